# Optimizing an MI355X kernel written in HIP

```python
import math
import jax
import jax.numpy as jnp
from jax import lax
import numpy as np

D_MODEL = 1024
BATCH = 4
SEQ = 4096
DEPTH = 2

GRID_W = 64
CTX_LEN = 256

N_BRANCH = 4
BRANCH_W = 256

S5_WIDTH = BRANCH_W
S5_GROUP = 16
S5_GROUPS = S5_WIDTH // S5_GROUP
S5_STATE = 64
S5_DT_MIN = 1e-3
S5_DT_MAX = 1e-1

HY_WIDTH = BRANCH_W
HY_ORDER = 2
HY_BANDS = 16
HY_EMB = 2 * HY_BANDS + 1
HY_FFN = 64
HY_SHORT = 3
HY_DECAY_TARGET = 1e-2
HY_FAST_DECAY_PCT = 0.3
HY_SLOW_DECAY_PCT = 1.5
HY_MIN_DECAY = math.log(HY_DECAY_TARGET) / HY_SLOW_DECAY_PCT
HY_MAX_DECAY = math.log(HY_DECAY_TARGET) / HY_FAST_DECAY_PCT

NA_HEADS = 4
NA_HEAD_DIM = BRANCH_W // NA_HEADS
NA_WIN_H = 8
NA_WIN_W = 16

SW_HEADS = 4
SW_KV_HEADS = 2
SW_HEAD_DIM = BRANCH_W // SW_HEADS
SW_WINDOW = 128
SW_BLOCK = 128

MLP_HIDDEN = 4 * D_MODEL
ROPE_BASE = 10000.0
LN_EPS = 1e-6
NEG_INF = -1e30
DEEPNORM_ALPHA = (2 * DEPTH) ** 0.25
DEEPNORM_BETA = (8 * DEPTH) ** -0.25

IN_WIDTHS = (S5_WIDTH, 3 * HY_WIDTH, 3 * BRANCH_W, (SW_HEADS + 2 * SW_KV_HEADS) * SW_HEAD_DIM, N_BRANCH * D_MODEL)
IN_TOTAL = sum(IN_WIDTHS)
IN_CUTS = tuple(int(v) for v in np.cumsum(IN_WIDTHS)[:-1])

F32 = jnp.float32

kernel_name = 'hybrid_s5_hyena_natten_swa_dit_trunk'


def _layernorm(x, gain=None, bias=None):
    xf = x.astype(F32)
    mu = jnp.mean(xf, axis=-1, keepdims=True)
    var = jnp.mean(jnp.square(xf - mu), axis=-1, keepdims=True)
    y = (xf - mu) * lax.rsqrt(var + LN_EPS)
    if gain is not None:
        y = y * gain.astype(F32) + bias.astype(F32)
    return y.astype(x.dtype)


def _modulate(x, shift, scale):
    return x * (1.0 + scale) + shift


def _softmax(s):
    return jax.nn.softmax(s.astype(F32), axis=-1)


def _axial_rope(n_tokens, head_dim):
    t = jnp.arange(n_tokens, dtype=jnp.int32)
    row = (t // GRID_W).astype(F32)
    col = (t % GRID_W).astype(F32)
    half = head_dim // 2
    inv = ROPE_BASE ** (-(jnp.arange(0, half, 2, dtype=F32) / half))
    ang = jnp.concatenate([row[:, None] * inv, col[:, None] * inv], axis=-1)
    return jnp.cos(ang), jnp.sin(ang)


def _apply_rope(x, cos, sin):
    xf = x.astype(F32)
    x1, x2 = jnp.split(xf, 2, axis=-1)
    c = cos[None, :, None, :]
    s = sin[None, :, None, :]
    return jnp.concatenate([x1 * c - x2 * s, x1 * s + x2 * c], axis=-1).astype(x.dtype)


def _s5_discretise(lam_re, lam_im, log_dt, b_re, b_im):
    lam_re = lam_re.astype(F32)
    lam_im = lam_im.astype(F32)
    dt = jnp.exp(log_dt.astype(F32))[:, None]
    mag = jnp.exp(lam_re * dt)
    a_re = mag * jnp.cos(lam_im * dt)
    a_im = mag * jnp.sin(lam_im * dt)
    den = lam_re ** 2 + lam_im ** 2
    f_re = ((a_re - 1.0) * lam_re + a_im * lam_im) / den
    f_im = (a_im * lam_re - (a_re - 1.0) * lam_im) / den
    b_re = b_re.astype(F32)
    b_im = b_im.astype(F32)
    bb_re = f_re[..., None] * b_re - f_im[..., None] * b_im
    bb_im = f_re[..., None] * b_im + f_im[..., None] * b_re
    return a_re, a_im, bb_re, bb_im


def _diag_scan(a_re, a_im, bu_re, bu_im, h0_re, h0_im, reverse):
    if reverse:
        bu_re = jnp.flip(bu_re, axis=1)
        bu_im = jnp.flip(bu_im, axis=1)
    bu_re = bu_re.at[:, 0].add(a_re * h0_re - a_im * h0_im)
    bu_im = bu_im.at[:, 0].add(a_re * h0_im + a_im * h0_re)
    ar = jnp.broadcast_to(a_re, bu_re.shape)
    ai = jnp.broadcast_to(a_im, bu_im.shape)

    def combine(e1, e2):
        a1r, a1i, b1r, b1i = e1
        a2r, a2i, b2r, b2i = e2
        return (a2r * a1r - a2i * a1i, a2r * a1i + a2i * a1r,
                a2r * b1r - a2i * b1i + b2r, a2r * b1i + a2i * b1r + b2i)

    _, _, h_re, h_im = lax.associative_scan(combine, (ar, ai, bu_re, bu_im), axis=1)
    if reverse:
        h_re = jnp.flip(h_re, axis=1)
        h_im = jnp.flip(h_im, axis=1)
    return h_re, h_im


def _s5_readout(h_re, h_im, c_re, c_im):
    b_, l_ = h_re.shape[:2]
    y = jnp.einsum('blgp,gnp->blgn', h_re, c_re) - jnp.einsum('blgp,gnp->blgn', h_im, c_im)
    return y.reshape(b_, l_, S5_WIDTH)


def _s5_glu(y, w_glu):
    g = jax.nn.gelu(y)
    return g * jax.nn.sigmoid(g @ w_glu.astype(F32))


def _s5_branch(u_lat, u_ctx, lam_re, lam_im, log_dt, b_re, b_im, c_re, c_im, d, w_glu, need_ctx_out):
    b_, n_lat, _ = u_lat.shape
    n_ctx = u_ctx.shape[1]
    ul = u_lat.astype(F32).reshape(b_, n_lat, S5_GROUPS, S5_GROUP)
    uc = u_ctx.astype(F32).reshape(b_, n_ctx, S5_GROUPS, S5_GROUP)
    zero = jnp.zeros((b_, S5_GROUPS, S5_STATE), F32)
    d = d.astype(F32)
    y_lat = d * u_lat.astype(F32)
    y_ctx = d * u_ctx.astype(F32) if need_ctx_out else None
    for direction in range(2):
        reverse = direction == 1
        a_re, a_im, bb_re, bb_im = _s5_discretise(lam_re[direction], lam_im[direction], log_dt[direction],
                                                  b_re[direction], b_im[direction])
        cr = c_re[direction].astype(F32)
        ci = c_im[direction].astype(F32)
        hc_re, hc_im = _diag_scan(a_re, a_im, jnp.einsum('blgn,gpn->blgp', uc, bb_re),
                                  jnp.einsum('blgn,gpn->blgp', uc, bb_im), zero, zero, reverse)
        end = 0 if reverse else n_ctx - 1
        hl_re, hl_im = _diag_scan(a_re, a_im, jnp.einsum('blgn,gpn->blgp', ul, bb_re),
                                  jnp.einsum('blgn,gpn->blgp', ul, bb_im), hc_re[:, end], hc_im[:, end], reverse)
        y_lat = y_lat + _s5_readout(hl_re, hl_im, cr, ci)
        if need_ctx_out:
            y_ctx = y_ctx + _s5_readout(hc_re, hc_im, cr, ci)
    out_lat = _s5_glu(y_lat, w_glu).astype(u_lat.dtype)
    out_ctx = _s5_glu(y_ctx, w_glu).astype(u_ctx.dtype) if need_ctx_out else None
    return out_lat, out_ctx


def _depthwise_conv(x, w, b):
    y = lax.conv_general_dilated(x, w.astype(x.dtype), window_strides=(1,), padding='SAME',
                                 dimension_numbers=('NWC', 'WIO', 'NWC'), feature_group_count=x.shape[-1])
    return y + b.astype(x.dtype)


def _hyena_filters(n_tokens, freq, w1, b1, w2, b2, w3):
    pos = jnp.arange(n_tokens, dtype=F32)[:, None]
    t = pos / max(n_tokens - 1, 1)
    bands = jnp.linspace(1e-4, HY_BANDS - 1, HY_BANDS, dtype=F32)[None]
    ang = 2.0 * math.pi * bands * pos / n_tokens
    feats = jnp.concatenate([t, jnp.cos(ang), -jnp.sin(ang)], axis=-1)
    freq = freq.astype(F32)
    h = jnp.sin(freq[0] * (feats @ w1.astype(F32) + b1.astype(F32)))
    h = jnp.sin(freq[1] * (h @ w2.astype(F32) + b2.astype(F32)))
    h = (h @ w3.astype(F32)).reshape(n_tokens, 2, HY_ORDER, HY_WIDTH)
    deltas = jnp.abs(jnp.linspace(HY_MIN_DECAY, HY_MAX_DECAY, HY_WIDTH, dtype=F32))
    return h * jnp.exp(-t[:, :, None, None] * deltas)


def _two_sided_fftconv(u, k_fwd, k_bwd):
    n = u.shape[1]
    k = jnp.concatenate([k_fwd, jnp.zeros_like(k_fwd[:1]), jnp.flip(k_bwd[1:], axis=0)], axis=0)
    k_f = jnp.fft.rfft(k, axis=0)
    u_f = jnp.fft.rfft(u.astype(F32), n=2 * n, axis=1)
    y = jnp.fft.irfft(u_f * k_f[None], n=2 * n, axis=1)[:, :n]
    return y.astype(u.dtype)


def _hyena_seq(z, conv_w, conv_b, freq, w1, b1, w2, b2, w3, bias):
    n = z.shape[1]
    z = _depthwise_conv(z, conv_w, conv_b)
    v, x1, x2 = jnp.split(z, 3, axis=-1)
    filt = _hyena_filters(n, freq, w1, b1, w2, b2, w3)
    for o, gate in enumerate((x1, x2)):
        v = gate * (_two_sided_fftconv(v, filt[:, 0, o], filt[:, 1, o]) + bias[o].astype(v.dtype) * v)
    return v


def _hyena_branch(z_lat, z_ctx, conv_w, conv_b, freq, w1, b1, w2, b2, w3, bias, need_ctx_out):
    out_lat = _hyena_seq(z_lat, conv_w, conv_b, freq, w1, b1, w2, b2, w3, bias)
    out_ctx = _hyena_seq(z_ctx, conv_w, conv_b, freq, w1, b1, w2, b2, w3, bias) if need_ctx_out else None
    return out_lat, out_ctx


def _ctx_attention(q, k, v, sink):
    b_, n, n_heads, dh = q.shape
    n_kv = k.shape[2]
    qg = q.reshape(b_, n, n_kv, n_heads // n_kv, dh)
    s = jnp.einsum('bqkgd,bckd->bkgqc', qg, k).astype(F32) * dh ** -0.5
    if sink is not None:
        s_sink = jnp.broadcast_to(sink.astype(F32).reshape(n_kv, n_heads // n_kv)[None, :, :, None, None],
                                  s.shape[:-1] + (1,))
        s = jnp.concatenate([s, s_sink], axis=-1)
    p = _softmax(s)[..., :n].astype(v.dtype)
    o = jnp.einsum('bkgqc,bckd->bqkgd', p, v)
    return o.reshape(b_, n, n_heads * dh)


def _neighbourhood_attention(q, k, v, k_ctx, v_ctx, rpb):
    b_, n, n_heads, dh = q.shape
    rows = n // GRID_W
    kh = min(NA_WIN_H, rows)
    scale = dh ** -0.5
    qg = q.reshape(b_, rows, GRID_W, n_heads, dh)
    kg = k.reshape(b_, rows, GRID_W, n_heads, dh)
    vg = v.reshape(b_, rows, GRID_W, n_heads, dh)
    r = jnp.arange(rows)
    row_idx = jnp.clip(r - kh // 2, 0, rows - kh)[:, None] + jnp.arange(kh)[None]
    kb = kg[:, row_idx]
    vb = vg[:, row_idx]
    col = jnp.arange(GRID_W)
    col_start = jnp.clip(col - NA_WIN_W // 2, 0, GRID_W - NA_WIN_W)
    col_ok = (col[None] >= col_start[:, None]) & (col[None] < col_start[:, None] + NA_WIN_W)
    off_r = row_idx - r[:, None] + (NA_WIN_H - 1)
    off_c = jnp.clip(col[None] - col[:, None], -(NA_WIN_W - 1), NA_WIN_W - 1) + (NA_WIN_W - 1)
    bias = rpb[:, off_r[:, None, :, None], off_c[None, :, None, :]]
    s_lat = jnp.einsum('brqhd,brkwhd->bhrqkw', qg, kb).astype(F32) * scale + bias.astype(F32)[None]
    s_lat = jnp.where(col_ok[:, None, :], s_lat, NEG_INF)
    n_lat = kh * GRID_W
    s_ctx = jnp.einsum('brqhd,bchd->bhrqc', qg, k_ctx).astype(F32) * scale
    s = jnp.concatenate([s_lat.reshape(b_, n_heads, rows, GRID_W, n_lat), s_ctx], axis=-1)
    p = _softmax(s)
    p_lat = p[..., :n_lat].reshape(b_, n_heads, rows, GRID_W, kh, GRID_W).astype(v.dtype)
    p_ctx = p[..., n_lat:].astype(v.dtype)
    o = jnp.einsum('bhrqkw,brkwhd->brqhd', p_lat, vb) + jnp.einsum('bhrqc,bchd->brqhd', p_ctx, v_ctx)
    return o.reshape(b_, n, n_heads * dh)


def _na_branch(z_lat, z_ctx, rpb, need_ctx_out):
    b_, n, _ = z_lat.shape
    n_ctx = z_ctx.shape[1]
    q, k, v = [t.reshape(b_, n, NA_HEADS, NA_HEAD_DIM) for t in jnp.split(z_lat, 3, axis=-1)]
    qc, kc, vc = [t.reshape(b_, n_ctx, NA_HEADS, NA_HEAD_DIM) for t in jnp.split(z_ctx, 3, axis=-1)]
    out_lat = _neighbourhood_attention(q, k, v, kc, vc, rpb)
    out_ctx = _ctx_attention(qc, kc, vc, None) if need_ctx_out else None
    return out_lat, out_ctx


def _window_attention(q, k, v, k_ctx, v_ctx, sink):
    b_, n, n_heads, dh = q.shape
    n_kv = k.shape[2]
    g_ = n_heads // n_kv
    nb = n // SW_BLOCK
    span = SW_BLOCK + 2 * SW_WINDOW
    scale = dh ** -0.5
    qb = q.reshape(b_, nb, SW_BLOCK, n_kv, g_, dh)
    pad = ((0, 0), (SW_WINDOW, SW_WINDOW), (0, 0), (0, 0))
    idx = jnp.arange(nb)[:, None] * SW_BLOCK + jnp.arange(span)[None]
    kb = jnp.pad(k, pad)[:, idx]
    vb = jnp.pad(v, pad)[:, idx]
    qpos = jnp.arange(nb)[:, None] * SW_BLOCK + jnp.arange(SW_BLOCK)[None]
    kpos = (idx - SW_WINDOW)[:, None, :]
    ok = (jnp.abs(kpos - qpos[:, :, None]) <= SW_WINDOW) & (kpos >= 0) & (kpos < n)
    s_lat = jnp.where(ok, jnp.einsum('bnqkgd,bnckd->bkgnqc', qb, kb).astype(F32) * scale, NEG_INF)
    s_ctx = jnp.einsum('bnqkgd,bckd->bkgnqc', qb, k_ctx).astype(F32) * scale
    s_sink = jnp.broadcast_to(sink.astype(F32).reshape(n_kv, g_)[None, :, :, None, None, None],
                              s_lat.shape[:-1] + (1,))
    p = _softmax(jnp.concatenate([s_lat, s_ctx, s_sink], axis=-1))
    n_ctx = k_ctx.shape[1]
    p_lat = p[..., :span].astype(v.dtype)
    p_ctx = p[..., span:span + n_ctx].astype(v.dtype)
    o = jnp.einsum('bkgnqc,bnckd->bnqkgd', p_lat, vb) + jnp.einsum('bkgnqc,bckd->bnqkgd', p_ctx, v_ctx)
    return o.reshape(b_, n, n_heads * dh)


def _split_gqa(z):
    b_, n, _ = z.shape
    qw = SW_HEADS * SW_HEAD_DIM
    kw = SW_KV_HEADS * SW_HEAD_DIM
    q = z[..., :qw].reshape(b_, n, SW_HEADS, SW_HEAD_DIM)
    k = z[..., qw:qw + kw].reshape(b_, n, SW_KV_HEADS, SW_HEAD_DIM)
    v = z[..., qw + kw:].reshape(b_, n, SW_KV_HEADS, SW_HEAD_DIM)
    return q, k, v


def _sw_branch(z_lat, z_ctx, sink, need_ctx_out):
    n = z_lat.shape[1]
    q, k, v = _split_gqa(z_lat)
    cos, sin = _axial_rope(n, SW_HEAD_DIM)
    q = _apply_rope(q, cos, sin)
    k = _apply_rope(k, cos, sin)
    qc, kc, vc = _split_gqa(z_ctx)
    out_lat = _window_attention(q, k, v, kc, vc, sink)
    out_ctx = _ctx_attention(qc, kc, vc, sink) if need_ctx_out else None
    return out_lat, out_ctx


def _merge(branches, gate_logits, w_branch, w_out):
    stacked = jnp.stack(branches, axis=2)
    proj = jnp.einsum('blnw,nwd->blnd', stacked, w_branch)
    gates = jax.nn.sigmoid(gate_logits.reshape(proj.shape))
    return jnp.einsum('blnd,blnd->bld', gates, proj) @ w_out


def _token_mixer(h, hc, w_in, s5_p, hy_p, na_rpb, sw_sink, w_branch, w_out, need_ctx_out):
    z = h @ w_in
    zc = hc @ w_in
    u_s5, z_hy, z_na, z_sw, z_gate = jnp.split(z, IN_CUTS, axis=-1)
    uc_s5, zc_hy, zc_na, zc_sw, zc_gate = jnp.split(zc, IN_CUTS, axis=-1)
    s5_l, s5_c = _s5_branch(u_s5, uc_s5, *s5_p, need_ctx_out)
    hy_l, hy_c = _hyena_branch(z_hy, zc_hy, *hy_p, need_ctx_out)
    na_l, na_c = _na_branch(z_na, zc_na, na_rpb, need_ctx_out)
    sw_l, sw_c = _sw_branch(z_sw, zc_sw, sw_sink, need_ctx_out)
    out = _merge((s5_l, hy_l, na_l, sw_l), z_gate, w_branch, w_out)
    out_c = _merge((s5_c, hy_c, na_c, sw_c), zc_gate, w_branch, w_out) if need_ctx_out else None
    return out, out_c


def _sqrelu_mlp(h, w1, w2):
    return jnp.square(jax.nn.relu(h @ w1)) @ w2


def _layer(x, xc, c, c_ctx, w_ada, b_ada, w_in, s5_p, hy_p, na_rpb, sw_sink, w_branch, w_out,
           ln1_g, ln1_b, w_mlp1, w_mlp2, ln2_g, ln2_b, need_ctx_out):
    mod = (jax.nn.silu(c) @ w_ada + b_ada)[:, None, :]
    mod_c = (jax.nn.silu(c_ctx) @ w_ada + b_ada)[None, None, :]
    sh_a, sc_a, g_a, sh_m, sc_m, g_m = jnp.split(mod, 6, axis=-1)
    csh_a, csc_a, cg_a, csh_m, csc_m, cg_m = jnp.split(mod_c, 6, axis=-1)
    h = _modulate(_layernorm(x), sh_a, sc_a)
    hc = _modulate(_layernorm(xc), csh_a, csc_a)
    mix, mix_c = _token_mixer(h, hc, w_in, s5_p, hy_p, na_rpb, sw_sink, w_branch, w_out, need_ctx_out)
    x = _layernorm(DEEPNORM_ALPHA * x + g_a * mix, ln1_g, ln1_b)
    x = _layernorm(DEEPNORM_ALPHA * x + g_m * _sqrelu_mlp(_modulate(_layernorm(x), sh_m, sc_m), w_mlp1, w_mlp2),
                   ln2_g, ln2_b)
    if not need_ctx_out:
        return x, None
    xc = _layernorm(DEEPNORM_ALPHA * xc + cg_a * mix_c, ln1_g, ln1_b)
    xc = _layernorm(DEEPNORM_ALPHA * xc + cg_m * _sqrelu_mlp(_modulate(_layernorm(xc), csh_m, csc_m), w_mlp1, w_mlp2),
                    ln2_g, ln2_b)
    return x, xc


def setup_inputs(seed: int = 0) -> dict:
    key = jax.random.key(seed)
    keys = iter(jax.random.split(key, 64))

    def nrm(shape, std):
        return std * jax.random.normal(next(keys), shape, F32)

    n_idx = jnp.arange(S5_STATE, dtype=F32)
    return {
        'x': nrm((BATCH, SEQ, D_MODEL), 1.0),
        'c': nrm((BATCH, D_MODEL), 1.0),
        'ctx': nrm((BATCH, CTX_LEN, D_MODEL), 1.0),
        'c_ctx': nrm((D_MODEL,), 1.0),
        'w_ada': nrm((DEPTH, D_MODEL, 6 * D_MODEL), 0.5 * D_MODEL ** -0.5),
        'b_ada': nrm((DEPTH, 6 * D_MODEL), 0.01),
        'w_in': nrm((DEPTH, D_MODEL, IN_TOTAL), D_MODEL ** -0.5),
        's5_lambda_re': -0.5 + nrm((DEPTH, 2, S5_GROUPS, S5_STATE), 0.01),
        's5_lambda_im': jnp.broadcast_to(math.pi * n_idx, (DEPTH, 2, S5_GROUPS, S5_STATE)),
        's5_log_dt': jax.random.uniform(next(keys), (DEPTH, 2, S5_GROUPS), F32,
                                        math.log(S5_DT_MIN), math.log(S5_DT_MAX)),
        's5_b_re': nrm((DEPTH, 2, S5_GROUPS, S5_STATE, S5_GROUP), (2 * S5_GROUP) ** -0.5),
        's5_b_im': nrm((DEPTH, 2, S5_GROUPS, S5_STATE, S5_GROUP), (2 * S5_GROUP) ** -0.5),
        's5_c_re': nrm((DEPTH, 2, S5_GROUPS, S5_GROUP, S5_STATE), S5_STATE ** -0.5),
        's5_c_im': nrm((DEPTH, 2, S5_GROUPS, S5_GROUP, S5_STATE), S5_STATE ** -0.5),
        's5_d': nrm((DEPTH, S5_WIDTH), 1.0),
        's5_w_glu': nrm((DEPTH, S5_WIDTH, S5_WIDTH), S5_WIDTH ** -0.5),
        'hy_conv_w': nrm((DEPTH, HY_SHORT, 1, 3 * HY_WIDTH), HY_SHORT ** -0.5),
        'hy_conv_b': nrm((DEPTH, 3 * HY_WIDTH), 0.01),
        'hy_freq': 1.0 + nrm((DEPTH, 2, HY_FFN), 0.01),
        'hy_w1': nrm((DEPTH, HY_EMB, HY_FFN), HY_EMB ** -0.5),
        'hy_b1': nrm((DEPTH, HY_FFN), 0.01),
        'hy_w2': nrm((DEPTH, HY_FFN, HY_FFN), HY_FFN ** -0.5),
        'hy_b2': nrm((DEPTH, HY_FFN), 0.01),
        'hy_w3': nrm((DEPTH, HY_FFN, 2 * HY_ORDER * HY_WIDTH), 0.02 * HY_FFN ** -0.5),
        'hy_bias': nrm((DEPTH, HY_ORDER, HY_WIDTH), 1.0),
        'na_rpb': nrm((DEPTH, NA_HEADS, 2 * NA_WIN_H - 1, 2 * NA_WIN_W - 1), 0.02),
        'sw_sink': nrm((DEPTH, SW_HEADS), 1.0),
        'w_branch': nrm((DEPTH, N_BRANCH, BRANCH_W, D_MODEL), BRANCH_W ** -0.5),
        'w_out': nrm((DEPTH, D_MODEL, D_MODEL), DEEPNORM_BETA * D_MODEL ** -0.5),
        'ln1_g': 1.0 + nrm((DEPTH, D_MODEL), 0.01),
        'ln1_b': nrm((DEPTH, D_MODEL), 0.01),
        'w_mlp1': nrm((DEPTH, D_MODEL, MLP_HIDDEN), D_MODEL ** -0.5),
        'w_mlp2': nrm((DEPTH, MLP_HIDDEN, D_MODEL), DEEPNORM_BETA * MLP_HIDDEN ** -0.5),
        'ln2_g': 1.0 + nrm((DEPTH, D_MODEL), 0.01),
        'ln2_b': nrm((DEPTH, D_MODEL), 0.01),
    }


def reference(x, c, ctx, c_ctx, w_ada, b_ada, w_in, s5_lambda_re, s5_lambda_im, s5_log_dt, s5_b_re, s5_b_im,
              s5_c_re, s5_c_im, s5_d, s5_w_glu, hy_conv_w, hy_conv_b, hy_freq, hy_w1, hy_b1, hy_w2, hy_b2, hy_w3,
              hy_bias, na_rpb, sw_sink, w_branch, w_out, ln1_g, ln1_b, w_mlp1, w_mlp2, ln2_g, ln2_b):
    xc = ctx
    for l in range(DEPTH):
        need_ctx_out = l < DEPTH - 1
        s5_p = (s5_lambda_re[l], s5_lambda_im[l], s5_log_dt[l], s5_b_re[l], s5_b_im[l],
                s5_c_re[l], s5_c_im[l], s5_d[l], s5_w_glu[l])
        hy_p = (hy_conv_w[l], hy_conv_b[l], hy_freq[l], hy_w1[l], hy_b1[l], hy_w2[l], hy_b2[l], hy_w3[l], hy_bias[l])
        x, xc = _layer(x, xc, c, c_ctx, w_ada[l], b_ada[l], w_in[l], s5_p, hy_p, na_rpb[l], sw_sink[l],
                       w_branch[l], w_out[l], ln1_g[l], ln1_b[l], w_mlp1[l], w_mlp2[l], ln2_g[l], ln2_b[l],
                       need_ctx_out)
    return x
```

```cpp
#include <hip/hip_runtime.h>
#include <hip/hip_cooperative_groups.h>
#include <stdint.h>
#include <stdio.h>
namespace cg = cooperative_groups;

#ifndef SINGLE_LAUNCH
#define SINGLE_LAUNCH 1
#endif

#define DI __device__ __forceinline__
typedef unsigned short u16;
typedef __attribute__((ext_vector_type(8))) short bf16x8;
typedef __attribute__((ext_vector_type(4))) short bf16x4;
typedef __attribute__((ext_vector_type(16))) float f32x16;
typedef __attribute__((ext_vector_type(4))) unsigned u32x4;

constexpr int D = 1024, NBATCH = 4, SEQ = 4096, CTX = 256;
constexpr int NLAT = NBATCH * SEQ, NCTX = NBATCH * CTX, NROW = NLAT + NCTX;
constexpr int ZW = 1152, INTOT = 6400, TOKS = SEQ + CTX;
constexpr int NCHUNK = 68;
constexpr float LN_EPS = 1e-6f;
constexpr float ALPHA = 1.41421356237f;

constexpr size_t OFF_MOD = 0;
constexpr size_t OFF_ROPE = 262144;
constexpr size_t OFF_S5A = OFF_ROPE + 8192;
constexpr size_t OFF_S5BB = OFF_S5A + 16384;
constexpr size_t SZ_S5ST = (size_t)2 * 4 * NCHUNK * 16 * 64 * 2 * 4;
constexpr size_t OFF_S5S = OFF_S5BB + 262144;
constexpr size_t OFF_S5H = OFF_S5S + SZ_S5ST;
constexpr size_t OFF_XC = OFF_S5H + SZ_S5ST;
constexpr size_t OFF_WIN = OFF_XC + (size_t)NCTX * D * 4;
constexpr size_t OFF_WBR = OFF_WIN + (size_t)INTOT * D * 2;
constexpr size_t OFF_WO = OFF_WBR + (size_t)4 * 1024 * 256 * 2;
constexpr size_t OFF_W1 = OFF_WO + (size_t)1024 * 1024 * 2;
constexpr size_t OFF_W2 = OFF_W1 + (size_t)4096 * 1024 * 2;
constexpr size_t OFF_WGLU = OFF_W2 + (size_t)4096 * 1024 * 2;
constexpr size_t OFF_FILTR = OFF_WGLU + (size_t)256 * 256 * 2;
constexpr size_t OFF_FCTX = OFF_FILTR + (size_t)2 * 256 * 8192 * 2;
constexpr size_t OFF_H = OFF_FCTX + (size_t)2 * 256 * 512 * 4;
constexpr size_t OFF_BIG = OFF_H + (size_t)NROW * D * 2;
constexpr size_t OFF_ZMIX = OFF_BIG;
constexpr size_t OFF_HYV1 = OFF_ZMIX + (size_t)NROW * ZW * 2;
constexpr size_t OFF_S5G = OFF_HYV1 + (size_t)NROW * 256 * 2;
constexpr size_t OFF_BR = OFF_S5G + (size_t)NROW * 256 * 2;
constexpr size_t OFF_VTNA = OFF_BR + (size_t)NROW * D * 2;
constexpr size_t OFF_VTSW = OFF_VTNA + (size_t)4 * 256 * TOKS * 2;
constexpr size_t OFF_HYT = OFF_VTSW + (size_t)4 * 128 * TOKS * 2;
constexpr size_t OFF_HYO = OFF_HYT + (size_t)4 * 768 * TOKS * 2;
constexpr size_t OFF_END = OFF_HYO + (size_t)4 * 256 * TOKS * 2;
constexpr size_t OFF_MERGED = OFF_BIG;
constexpr size_t OFF_HID = OFF_BIG;
static_assert((size_t)NROW * 4096 * 2 <= OFF_END - OFF_BIG, "hid alias");
constexpr size_t OFF_BAR = OFF_END;
constexpr int NCOL = 4 * NCHUNK;
constexpr size_t OFF_K2 = OFF_BAR + 16384;
constexpr size_t OFF_PT = OFF_K2 + (size_t)16 * 127 * 256 * 2;
constexpr size_t OFF_ET = OFF_PT + (size_t)16 * 256 * 1024 * 2;
constexpr size_t OFF_HB = OFF_ET + (size_t)16 * 1024 * 256 * 2;
constexpr size_t OFF_END2 = OFF_HB + (size_t)16 * NCOL * 256 * 2;
constexpr size_t OFF_S5D = OFF_END2;
static_assert(OFF_S5D + 65536 <= (size_t)256 * 1024 * 1024, "ws");

constexpr int LDT = 72;
constexpr int TILE_ELEMS = 128 * LDT;
constexpr int SMEM_BYTES = 4 * TILE_ELEMS * 2;

struct Params {
  const float* in[35];
  float* out;
  char* ws;
  int ph_lo, ph_hi;
};

DI int tidx() { int t = threadIdx.x; asm volatile("" : "+v"(t)); return t; }
typedef float f32x2 __attribute__((ext_vector_type(2)));
typedef __bf16 bf16x2_t __attribute__((ext_vector_type(2)));
DI unsigned pack2(float a, float b) { f32x2 v = {a, b}; bf16x2_t r = __builtin_convertvector(v, bf16x2_t); return __builtin_bit_cast(unsigned, r); }
DI u16 f2bf(float x) { return (u16)(pack2(x, 0.f) & 0xffffu); }
DI float bf2f(u16 v) { return __uint_as_float(((unsigned)v) << 16); }
DI int crow(int i, int h) { return (i & 3) + 8 * (i >> 2) + 4 * h; }
DI float wsum(float v) { for (int o = 32; o > 0; o >>= 1) v += __shfl_xor(v, o); return v; }
DI float sigmoidf_(float x) { return 1.f / (1.f + __expf(-x)); }
DI float gelu_tanh(float x) { float u = 0.7978845608028654f * (x + 0.044715f * x * x * x); return 0.5f * x * (1.f + tanhf(u)); }
#define MFMA32(a, b, c) __builtin_amdgcn_mfma_f32_32x32x16_bf16((a), (b), (c), 0, 0, 0)

DI int bidx_of_row(int r) { return r < NLAT ? (r >> 12) : 4; }
DI float* xrow(const Params& p, int r) { return r < NLAT ? p.out + (size_t)r * D : (float*)(p.ws + OFF_XC) + (size_t)(r - NLAT) * D; }
DI const float* xin_row(const Params& p, int l, int r) {
  if (l == 0) return r < NLAT ? p.in[0] + (size_t)r * D : p.in[2] + (size_t)(r - NLAT) * D;
  return xrow(p, r);
}
DI const float* modp(const Params& p, int l, int bi, int part) { return (const float*)(p.ws + OFF_MOD) + ((size_t)(l * 5 + bi) * 6144 + part * 1024); }

template <int NI, class FA, class FB>
DI void g_load(u32x4 (&ra)[4], u32x4 (&rb)[2 * NI], FA fa, FB fb, int kt) {
#pragma unroll
  for (int i = 0; i < 4; ++i) ra[i] = *(const u32x4*)fa(i, kt);
#pragma unroll
  for (int i = 0; i < 2 * NI; ++i) rb[i] = *(const u32x4*)fb(i, kt);
}
template <int NI>
DI void g_store(const u32x4 (&ra)[4], const u32x4 (&rb)[2 * NI], u16* sa, u16* sb) {
#pragma unroll
  for (int i = 0; i < 4; ++i) *(u32x4*)(sa + i * 32 * LDT) = ra[i];
#pragma unroll
  for (int i = 0; i < 2 * NI; ++i) *(u32x4*)(sb + i * 32 * LDT) = rb[i];
}
template <int NI, bool SWAP = false>
DI void g_compute(f32x16 (&acc)[2][NI], const u16* ab, const u16* bb) {
  __builtin_amdgcn_s_setprio(1);
#pragma unroll
  for (int ks = 0; ks < 4; ++ks) {
    bf16x8 a0 = *(const bf16x8*)(ab + ks * 16), a1 = *(const bf16x8*)(ab + 32 * LDT + ks * 16);
#pragma unroll
    for (int ni = 0; ni < NI; ++ni) {
      bf16x8 b0 = *(const bf16x8*)(bb + ni * 32 * LDT + ks * 16);
      if (SWAP) {
        acc[0][ni] = MFMA32(b0, a0, acc[0][ni]);
        acc[1][ni] = MFMA32(b0, a1, acc[1][ni]);
      } else {
        acc[0][ni] = MFMA32(a0, b0, acc[0][ni]);
        acc[1][ni] = MFMA32(a1, b0, acc[1][ni]);
      }
    }
  }
  __builtin_amdgcn_s_setprio(0);
}
template <int NI, bool SWAP = false, class FA, class FB>
DI void gemm_acc_f(FA fa, FB fb, int nk, f32x16 (&acc)[2][NI], u16* sm) {
  const int tid = tidx(), lane = tid & 63, w = tid >> 6, wm = w >> 1, wn = w & 1, r = lane & 31, h = lane >> 5;
  const int lrow = tid >> 3, lch = tid & 7;
  u16* sa0 = sm + lrow * LDT + lch * 8;
  u16* sa1 = sa0 + TILE_ELEMS;
  u16* sb0 = sm + 2 * TILE_ELEMS + lrow * LDT + lch * 8;
  u16* sb1 = sb0 + TILE_ELEMS;
  const u16* ab0 = sm + (wm * 64 + r) * LDT + h * 8;
  const u16* ab1 = ab0 + TILE_ELEMS;
  const u16* bb0 = sm + 2 * TILE_ELEMS + (wn * 32 * NI + r) * LDT + h * 8;
  const u16* bb1 = bb0 + TILE_ELEMS;
  u32x4 ra0[4], ra1[4], rb0[2 * NI], rb1[2 * NI];
  g_load<NI>(ra0, rb0, fa, fb, 0);
  g_load<NI>(ra1, rb1, fa, fb, 1);
  g_store<NI>(ra0, rb0, sa0, sb0);
  __syncthreads();
  for (int kt = 0; kt < nk; kt += 2) {
    if (kt + 2 < nk) g_load<NI>(ra0, rb0, fa, fb, kt + 2);
    g_compute<NI, SWAP>(acc, ab0, bb0);
    g_store<NI>(ra1, rb1, sa1, sb1);
    __syncthreads();
    if (kt + 3 < nk) g_load<NI>(ra1, rb1, fa, fb, kt + 3);
    g_compute<NI, SWAP>(acc, ab1, bb1);
    if (kt + 2 < nk) g_store<NI>(ra0, rb0, sa0, sb0);
    __syncthreads();
  }
}
template <int NI, class FA, class FB>
DI void gemm_acc_f1(FA fa, FB fb, int nk, f32x16 (&acc)[2][NI], u16* sm) {
  const int tid = tidx(), lane = tid & 63, w = tid >> 6, wm = w >> 1, wn = w & 1, r = lane & 31, h = lane >> 5;
  const int lrow = tid >> 3, lch = tid & 7;
  u16* sa0 = sm + lrow * LDT + lch * 8;
  u16* sb0 = sm + 2 * TILE_ELEMS + lrow * LDT + lch * 8;
  const u16* ab0 = sm + (wm * 64 + r) * LDT + h * 8;
  const u16* bb0 = sm + 2 * TILE_ELEMS + (wn * 32 * NI + r) * LDT + h * 8;
  u32x4 ra0[4], rb0[2 * NI];
  g_load<NI>(ra0, rb0, fa, fb, 0);
  g_store<NI>(ra0, rb0, sa0, sb0);
  __syncthreads();
  for (int kt = 0; kt < nk; ++kt) {
    const int cur = kt & 1;
    if (kt + 1 < nk) g_load<NI>(ra0, rb0, fa, fb, kt + 1);
    g_compute<NI>(acc, ab0 + cur * TILE_ELEMS, bb0 + cur * TILE_ELEMS);
    if (kt + 1 < nk) g_store<NI>(ra0, rb0, sa0 + (cur ^ 1) * TILE_ELEMS, sb0 + (cur ^ 1) * TILE_ELEMS);
    __syncthreads();
  }
}
template <int NI, bool SWAP = false>
DI void gemm_acc(const u16* __restrict__ A, int lda, const u16* __restrict__ B, int ldb, int K, f32x16 (&acc)[2][NI], u16* sm) {
  const int tid = tidx(), lrow = tid >> 3, lch = tid & 7;
  const u16* ga = A + (size_t)lrow * lda + lch * 8;
  const u16* gb = B + (size_t)lrow * ldb + lch * 8;
  gemm_acc_f<NI, SWAP>([=](int i, int kt) { return ga + (size_t)i * 32 * lda + kt * 64; },
                       [=](int i, int kt) { return gb + (size_t)i * 32 * ldb + kt * 64; }, K >> 6, acc, sm);
}
template <int NI>
DI void zero_acc(f32x16 (&acc)[2][NI]) {
#pragma unroll
  for (int a = 0; a < 2; ++a)
#pragma unroll
    for (int b = 0; b < NI; ++b)
#pragma unroll
      for (int i = 0; i < 16; ++i) acc[a][b][i] = 0.f;
}
#define FOR_ACC(acc, m0, n0, BODY)                                                                  \
  {                                                                                                 \
    const int lane_ = tidx() & 63, w_ = tidx() >> 6, r_ = lane_ & 31, h_ = lane_ >> 5;     \
    _Pragma("unroll") for (int mi_ = 0; mi_ < 2; ++mi_) _Pragma("unroll") for (int ni_ = 0; ni_ < 2; ++ni_) \
    _Pragma("unroll") for (int i_ = 0; i_ < 16; ++i_) {                                             \
      const int row = (m0) + (w_ >> 1) * 64 + mi_ * 32 + crow(i_, h_);                              \
      const int col = (n0) + (w_ & 1) * 64 + ni_ * 32 + r_;                                         \
      const float v = acc[mi_][ni_][i_];                                                               \
      BODY                                                                                          \
    }                                                                                               \
  }

DI void s5_disc_compute(const Params& p, int l, int si, float& lm, float& th, float& f_re, float& f_im);
DI void phase_mod(const Params& p, char* smem) {
  const int tid = tidx();
  float* sc = (float*)smem;
  float* red = sc + 5 * 1024;
  for (int i = tid; i < 5 * 1024; i += 256) {
    int j = i >> 10, k = i & 1023;
    float v = j < 4 ? p.in[1][j * 1024 + k] : p.in[3][k];
    sc[i] = v / (1.f + __expf(-v));
  }
  __syncthreads();
  for (int item = blockIdx.x; item < 2 * 96; item += gridDim.x) {
    const int l = item / 96, ct = item % 96, cl = tid & 63, kg = tid >> 6, col = ct * 64 + cl;
    const float* W = p.in[4] + (size_t)l * 1024 * 6144 + col;
    float a0 = 0, a1 = 0, a2 = 0, a3 = 0, a4 = 0;
#pragma unroll 8
    for (int k = kg * 256; k < kg * 256 + 256; ++k) {
      float wv = W[(size_t)k * 6144];
      a0 += sc[k] * wv; a1 += sc[1024 + k] * wv; a2 += sc[2048 + k] * wv; a3 += sc[3072 + k] * wv; a4 += sc[4096 + k] * wv;
    }
    float* rr = red + (kg * 64 + cl) * 5;
    rr[0] = a0; rr[1] = a1; rr[2] = a2; rr[3] = a3; rr[4] = a4;
    __syncthreads();
    if (tid < 64) {
      float bv = p.in[5][l * 6144 + col];
      float* mo = (float*)(p.ws + OFF_MOD);
      for (int j = 0; j < 5; ++j) {
        float s = red[(0 * 64 + cl) * 5 + j] + red[(1 * 64 + cl) * 5 + j] + red[(2 * 64 + cl) * 5 + j] + red[(3 * 64 + cl) * 5 + j];
        mo[(size_t)(l * 5 + j) * 6144 + col] = s + bv;
      }
    }
    __syncthreads();
  }
  for (int i = blockIdx.x * 256 + tid; i < 4096; i += gridDim.x * 256) {
    float lm, th, fr, fi; s5_disc_compute(p, i >> 11, i & 2047, lm, th, fr, fi);
    *(float4*)((float*)(p.ws + OFF_S5D) + (size_t)i * 4) = make_float4(lm, th, fr, fi);
  }
  for (int i = blockIdx.x * 256 + tid; i < 1024; i += gridDim.x * 256) {
    int pos = i >> 4, m = i & 15;
    float inv = powf(10000.f, -(float)m / 16.f);
    float s, c; sincosf((float)pos * inv, &s, &c);
    float* rt = (float*)(p.ws + OFF_ROPE);
    rt[i * 2] = c; rt[i * 2 + 1] = s;
  }
}

DI void convT_tile(const float* __restrict__ src, int K, int N, u16* __restrict__ dst, int kt, int nt, float* tile) {
  const int tid = tidx();
#pragma unroll
  for (int q = 0; q < 4; ++q) {
    const int e = tid + q * 256, i = e >> 4, j4 = (e & 15) * 4;
    const float4 v = *(const float4*)(src + (size_t)(kt * 64 + i) * N + nt * 64 + j4);
    tile[i * 65 + j4] = v.x; tile[i * 65 + j4 + 1] = v.y; tile[i * 65 + j4 + 2] = v.z; tile[i * 65 + j4 + 3] = v.w;
  }
  __syncthreads();
#pragma unroll
  for (int q = 0; q < 2; ++q) {
    const int e = tid + q * 256, j = e >> 3, i8 = (e & 7) * 8;
    uint4 o;
    o.x = pack2(tile[(i8 + 0) * 65 + j], tile[(i8 + 1) * 65 + j]); o.y = pack2(tile[(i8 + 2) * 65 + j], tile[(i8 + 3) * 65 + j]);
    o.z = pack2(tile[(i8 + 4) * 65 + j], tile[(i8 + 5) * 65 + j]); o.w = pack2(tile[(i8 + 6) * 65 + j], tile[(i8 + 7) * 65 + j]);
    *(uint4*)(dst + (size_t)(nt * 64 + j) * K + kt * 64 + i8) = o;
  }
  __syncthreads();
}

DI void ln_load(const float* __restrict__ src, float (&v)[16]) {
  const int lane = tidx() & 63;
#pragma unroll
  for (int i = 0; i < 4; ++i) { float4 t = *(const float4*)(src + i * 256 + lane * 4); v[i * 4] = t.x; v[i * 4 + 1] = t.y; v[i * 4 + 2] = t.z; v[i * 4 + 3] = t.w; }
}
DI void ln_norm(float (&v)[16]) {
  float s = 0;
#pragma unroll
  for (int i = 0; i < 16; ++i) s += v[i];
  float mu = wsum(s) * (1.f / 1024.f);
  float q = 0;
#pragma unroll
  for (int i = 0; i < 16; ++i) { v[i] -= mu; q += v[i] * v[i]; }
  float rstd = rsqrtf(wsum(q) * (1.f / 1024.f) + LN_EPS);
#pragma unroll
  for (int i = 0; i < 16; ++i) v[i] *= rstd;
}
DI void ln_store_mod(const float (&v)[16], const float* __restrict__ sh, const float* __restrict__ scl, u16* __restrict__ dst) {
  const int lane = tidx() & 63;
#pragma unroll
  for (int i = 0; i < 4; ++i) {
    int c = i * 256 + lane * 4;
    float4 s4 = *(const float4*)(sh + c), c4 = *(const float4*)(scl + c);
    uint2 o;
    o.x = pack2(v[i * 4] * (1.f + c4.x) + s4.x, v[i * 4 + 1] * (1.f + c4.y) + s4.y);
    o.y = pack2(v[i * 4 + 2] * (1.f + c4.z) + s4.z, v[i * 4 + 3] * (1.f + c4.w) + s4.w);
    *(uint2*)(dst + c) = o;
  }
}
DI void ln_affine(float (&v)[16], const float* __restrict__ g, const float* __restrict__ b) {
  const int lane = tidx() & 63;
#pragma unroll
  for (int i = 0; i < 4; ++i) {
    int c = i * 256 + lane * 4;
    float4 g4 = *(const float4*)(g + c), b4 = *(const float4*)(b + c);
    v[i * 4] = v[i * 4] * g4.x + b4.x; v[i * 4 + 1] = v[i * 4 + 1] * g4.y + b4.y; v[i * 4 + 2] = v[i * 4 + 2] * g4.z + b4.z; v[i * 4 + 3] = v[i * 4 + 3] * g4.w + b4.w;
  }
}
DI void ln_store_f32(const float (&v)[16], float* __restrict__ dst) {
  const int lane = tidx() & 63;
#pragma unroll
  for (int i = 0; i < 4; ++i) *(float4*)(dst + i * 256 + lane * 4) = make_float4(v[i * 4], v[i * 4 + 1], v[i * 4 + 2], v[i * 4 + 3]);
}

DI void hyena_filter_item(const Params& p, int l, int n, int pos0, float* sm) {
  const int tid = tidx();
  float* feats = sm;
  float* h1 = sm + 9 * 36;
  float* h2 = h1 + 9 * 64;
  for (int e = tid; e < 9 * 33; e += 256) {
    int pi = e / 33, k = e % 33, pos = pos0 + pi;
    float f;
    if (k == 0) f = (float)pos / (float)(n - 1);
    else {
      int bi = (k - 1) & 15;
      float band = 1e-4f + (15.f - 1e-4f) * (float)bi / 15.f;
      float ang = 6.283185307179586f * band * (float)pos / (float)n;
      float sn, cs; sincosf(ang, &sn, &cs);
      f = k <= 16 ? cs : -sn;
    }
    feats[pi * 36 + k] = f;
  }
  __syncthreads();
  for (int e = tid; e < 9 * 64; e += 256) {
    int pi = e >> 6, j = e & 63;
    const float* w1 = p.in[19] + (size_t)l * 33 * 64;
    float a = p.in[20][l * 64 + j];
    for (int k = 0; k < 33; ++k) a += feats[pi * 36 + k] * w1[k * 64 + j];
    h1[e] = sinf(p.in[18][(l * 2 + 0) * 64 + j] * a);
  }
  __syncthreads();
  for (int e = tid; e < 9 * 64; e += 256) {
    int pi = e >> 6, j = e & 63;
    const float* w2 = p.in[21] + (size_t)l * 64 * 64;
    float a = p.in[22][l * 64 + j];
    for (int k = 0; k < 64; ++k) a += h1[pi * 64 + k] * w2[k * 64 + j];
    h2[e] = sinf(p.in[18][(l * 2 + 1) * 64 + j] * a);
  }
  __syncthreads();
  const float* w3 = p.in[23] + (size_t)l * 64 * 1024;
  for (int q = 0; q < 4; ++q) {
    const int idx = q * 256 + tid, dirn = idx >> 9, o = (idx >> 8) & 1, c = idx & 255;
    float wc[64];
#pragma unroll
    for (int k = 0; k < 64; ++k) wc[k] = w3[k * 1024 + idx];
    const float delta = fabsf(-3.0701134573253944f + (-15.350567286626972f + 3.0701134573253944f) * (float)c / 255.f);
    float out[8];
#pragma unroll
    for (int e = 0; e < 8; ++e) {
      const int pi = e + dirn, pos = pos0 + pi;
      float a = 0.f;
#pragma unroll
      for (int k = 0; k < 64; k += 4) {
        float4 hh = *(const float4*)(h2 + pi * 64 + k);
        a += hh.x * wc[k] + hh.y * wc[k + 1] + hh.z * wc[k + 2] + hh.w * wc[k + 3];
      }
      a *= __expf(-((float)pos / (float)(n - 1)) * delta);
      if (dirn == 0 && pos == 0) a += p.in[24][(l * 2 + o) * 256 + c];
      if (pos >= n) a = 0.f;
      out[e] = a;
    }
    if (n == 4096) {
      u16* FR = (u16*)(p.ws + OFF_FILTR) + ((size_t)o * 256 + c) * 8192;
      uint4 v;
      if (dirn == 0) {
        v.x = pack2(out[7], out[6]); v.y = pack2(out[5], out[4]); v.z = pack2(out[3], out[2]); v.w = pack2(out[1], out[0]);
        *(uint4*)(FR + 4088 - pos0) = v;
      } else {
        v.x = pack2(out[0], out[1]); v.y = pack2(out[2], out[3]); v.z = pack2(out[4], out[5]); v.w = pack2(out[6], out[7]);
        *(uint4*)(FR + 4096 + pos0) = v;
      }
    } else {
      float* FC = (float*)(p.ws + OFF_FCTX) + ((size_t)o * 256 + c) * 512 + 256;
#pragma unroll
      for (int e = 0; e < 8; ++e) {
        const int pos = pos0 + e + dirn;
        if (pos < n) { if (dirn == 0) FC[pos] = out[e]; else FC[-pos] = out[e]; }
      }
    }
  }
  __syncthreads();
}

DI void s5_k2_thread(const Params& p, int l, int idx);
DI void s5_pe_thread(const Params& p, int l, int idx);
DI void phase_prep(const Params& p, int l, char* smem, bool do_abc, bool do_d, bool do_tab) {
  const int tid = tidx();
  float* smf = (float*)smem;
  if (do_abc) {
  for (int item = blockIdx.x; item < 4176; item += gridDim.x) {
    int it = item;
    if (it < 1600) { convT_tile(p.in[6] + (size_t)l * 1024 * INTOT, 1024, INTOT, (u16*)(p.ws + OFF_WIN), it / 100, it % 100, smf); continue; }
    it -= 1600;
    if (it < 256) { int n = it >> 6, t = it & 63; convT_tile(p.in[27] + ((size_t)l * 4 + n) * 256 * 1024, 256, 1024, (u16*)(p.ws + OFF_WBR) + (size_t)n * 1024 * 256, t >> 4, t & 15, smf); continue; }
    it -= 256;
    if (it < 256) { convT_tile(p.in[28] + (size_t)l * 1024 * 1024, 1024, 1024, (u16*)(p.ws + OFF_WO), it >> 4, it & 15, smf); continue; }
    it -= 256;
    if (it < 1024) { convT_tile(p.in[31] + (size_t)l * 1024 * 4096, 1024, 4096, (u16*)(p.ws + OFF_W1), it >> 6, it & 63, smf); continue; }
    it -= 1024;
    if (it < 1024) { convT_tile(p.in[32] + (size_t)l * 4096 * 1024, 4096, 1024, (u16*)(p.ws + OFF_W2), it >> 4, it & 15, smf); continue; }
    it -= 1024;
    convT_tile(p.in[15] + (size_t)l * 256 * 256, 256, 256, (u16*)(p.ws + OFF_WGLU), it >> 2, it & 3, smf);
  }
  for (int item = blockIdx.x; item < 512 + 32; item += gridDim.x) {
    if (item < 512) hyena_filter_item(p, l, 4096, item * 8, smf);
    else hyena_filter_item(p, l, 256, (item - 512) * 8, smf);
  }
  for (int i = blockIdx.x * 256 + tid; i < 2048; i += gridDim.x * 256) {
    int dir = i >> 10, g = (i >> 6) & 15;
    float lre = p.in[7][l * 2048 + i], lim = p.in[8][l * 2048 + i];
    float dt = __expf(p.in[9][(l * 2 + dir) * 16 + g]);
    float th = lim * dt, sn, cs; sincosf(th, &sn, &cs);
    float em1 = expm1f(lre * dt), mag = em1 + 1.f;
    float a_re = mag * cs, a_im = mag * sn;
    float sh = sinf(0.5f * th);
    float are_m1 = em1 * cs - 2.f * sh * sh;
    float den = lre * lre + lim * lim;
    float f_re = (are_m1 * lre + a_im * lim) / den, f_im = (a_im * lre - are_m1 * lim) / den;
    float* A = (float*)(p.ws + OFF_S5A);
    A[i * 2] = a_re; A[i * 2 + 1] = a_im;
    float* BB = (float*)(p.ws + OFF_S5BB) + (size_t)i * 32;
    const float* bre = p.in[10] + ((size_t)l * 2048 + i) * 16;
    const float* bim = p.in[11] + ((size_t)l * 2048 + i) * 16;
    for (int n = 0; n < 16; ++n) { float br = bre[n], bi = bim[n]; BB[n * 2] = f_re * br - f_im * bi; BB[n * 2 + 1] = f_re * bi + f_im * br; }
  }
  }
  if (do_tab) {
    for (int i = blockIdx.x * 256 + tid; i < 65536; i += gridDim.x * 256) s5_k2_thread(p, l, i);
    for (int i = blockIdx.x * 256 + tid; i < 131072; i += gridDim.x * 256) s5_pe_thread(p, l, i);
  }
  if (l == 0 && do_d) {
    const int w = tid >> 6;
    const int rs = gridDim.x * 4;
    float v[16], vn[16];
    int r = blockIdx.x * 4 + w;
    if (r < NROW) ln_load(xin_row(p, 0, r), vn);
    for (; r < NROW; r += rs) {
#pragma unroll
      for (int i = 0; i < 16; ++i) v[i] = vn[i];
      if (r + rs < NROW) ln_load(xin_row(p, 0, r + rs), vn);
      ln_norm(v);
      int bi = bidx_of_row(r);
      ln_store_mod(v, modp(p, 0, bi, 0), modp(p, 0, bi, 1), (u16*)(p.ws + OFF_H) + (size_t)r * D);
    }
  }
}

DI void phase_inproj(const Params& p, int l, char* smem) {
  const u16* H = (const u16*)(p.ws + OFF_H);
  const u16* W = (const u16*)(p.ws + OFF_WIN);
  u16* Z = (u16*)(p.ws + OFF_ZMIX);
  const float* rope = (const float*)(p.ws + OFF_ROPE);
  const int lane = tidx() & 63, w = tidx() >> 6, r = lane & 31, h = lane >> 5;
  const bool xcd_order = (gridDim.x & 7) == 0;
  const int nloc = xcd_order ? 17 * 18 : 136 * 18, q0 = xcd_order ? (int)(blockIdx.x >> 3) : (int)blockIdx.x, qs = xcd_order ? (int)(gridDim.x >> 3) : (int)gridDim.x;
  for (int q = q0; q < nloc; q += qs) {
    const int mt = xcd_order ? (int)(blockIdx.x & 7) + 8 * (q / 18) : q / 18, nt = q % 18, m0 = mt * 128, n0 = nt * 128;
    f32x16 acc[2][2];
    zero_acc<2>(acc);
    const int cbase = n0 + (w & 1) * 64, rbase = m0 + (w >> 1) * 64;
    const bool thy = cbase >= 256 && cbase < 1024, vna = cbase >= 1536 && cbase < 1792, vsw = cbase >= 2176;
    const bool tr = (n0 >= 256 && n0 < 1024) || (n0 >= 1536 && n0 < 1792) || n0 >= 2176;
    if (tr) {
      gemm_acc<2, true>(H + (size_t)m0 * D, D, W + (size_t)n0 * D, D, 1024, acc, (u16*)smem);
      u16* VT = (u16*)(p.ws + (thy ? OFF_HYT : (vna ? OFF_VTNA : OFF_VTSW)));
      const int CV = thy ? 768 : (vna ? 256 : 128), c0 = thy ? 256 : (vna ? 1536 : 2176);
#pragma unroll
      for (int mi = 0; mi < 2; ++mi) {
        const int row = rbase + mi * 32 + r;
        int b, tok;
        if (row < NLAT) { b = row >> 12; tok = row & 4095; } else { int rr = row - NLAT; b = rr >> 8; tok = 4096 + (rr & 255); }
        u16* vrow = VT + (size_t)(b * CV + cbase - c0) * TOKS + tok;
#pragma unroll
        for (int ni = 0; ni < 2; ++ni)
#pragma unroll
          for (int i = 0; i < 16; ++i) vrow[(size_t)(ni * 32 + crow(i, h)) * TOKS] = f2bf(acc[mi][ni][i]);
      }
    } else {
      gemm_acc<2>(H + (size_t)m0 * D, D, W + (size_t)n0 * D, D, 1024, acc, (u16*)smem);
      if (cbase >= 1792 && m0 < NLAT) {
#pragma unroll
        for (int mi = 0; mi < 2; ++mi)
#pragma unroll
          for (int i = 0; i < 16; ++i) {
            int t = (rbase + mi * 32 + crow(i, h)) & 4095;
            int pos = r < 16 ? (t >> 6) : (t & 63);
            float cs = rope[(pos * 16 + (r & 15)) * 2], sn = rope[(pos * 16 + (r & 15)) * 2 + 1];
            float x1 = acc[mi][0][i], x2 = acc[mi][1][i];
            acc[mi][0][i] = x1 * cs - x2 * sn;
            acc[mi][1][i] = x1 * sn + x2 * cs;
          }
      }
      const int zoff = cbase < 256 ? 0 : (cbase < 1536 ? 768 : 1024);
      FOR_ACC(acc, m0, n0, { Z[(size_t)row * ZW + col - zoff] = f2bf(v); })
    }
  }
}

struct AttnSt { f32x16 o0, o1; float m, l; };
DI void attn_init(AttnSt& S) {
#pragma unroll
  for (int i = 0; i < 16; ++i) { S.o0[i] = 0.f; S.o1[i] = 0.f; }
  S.m = -1e30f; S.l = 0.f;
}
template <class SF>
DI void attn_compute(AttnSt& S, const bf16x8 (&qf)[4], const bf16x8 (&kf)[4], const bf16x8 (&vf)[4], SF sf) {
  f32x16 st;
#pragma unroll
  for (int i = 0; i < 16; ++i) st[i] = 0.f;
#pragma unroll
  for (int ks = 0; ks < 4; ++ks) st = MFMA32(kf[ks], qf[ks], st);
  float mx = -1e30f;
#pragma unroll
  for (int i = 0; i < 16; ++i) { float s = sf(i, st[i] * 0.125f); st[i] = s; mx = fmaxf(mx, s); }
  mx = fmaxf(mx, __shfl_xor(mx, 32));
  const float mn = fmaxf(S.m, mx), alpha = __expf(S.m - mn);
  S.m = mn;
  float ps = 0.f;
#pragma unroll
  for (int i = 0; i < 16; ++i) { float e = __expf(st[i] - mn); st[i] = e; ps += e; }
  S.l = S.l * alpha + ps;
#pragma unroll
  for (int i = 0; i < 16; ++i) { S.o0[i] *= alpha; S.o1[i] *= alpha; }
#pragma unroll
  for (int s = 0; s < 2; ++s) {
    union { unsigned u[4]; bf16x8 v; } pf;
#pragma unroll
    for (int j = 0; j < 4; ++j) pf.u[j] = pack2(st[8 * s + 2 * j], st[8 * s + 2 * j + 1]);
    S.o0 = MFMA32(vf[2 * s], pf.v, S.o0);
    S.o1 = MFMA32(vf[2 * s + 1], pf.v, S.o1);
  }
}
constexpr int AT_KLD = 72, AT_VLD = 36, AT_BUF = 32 * AT_KLD + 64 * AT_VLD;
template <class PF, class SF>
DI void attn_run(AttnSt& S, const bf16x8 (&qf)[4], int nblk, PF pf, SF sf, u16* lds  ) {
  const int lane = tidx() & 63, r = lane & 31, h = lane >> 5;
  const int kr = lane >> 3, kc = (lane & 7) * 8, vr = lane >> 2, vc = (lane & 3) * 8;
  u32x4 gk[4], gv[4];
  {
    const u16 *kb, *vb;
    pf(0, kb, vb);
#pragma unroll
    for (int j = 0; j < 4; ++j) { gk[j] = *(const u32x4*)(kb + (size_t)(kr + 8 * j) * ZW + kc); gv[j] = *(const u32x4*)(vb + (size_t)(vr + 16 * j) * TOKS + vc); }
#pragma unroll
    for (int j = 0; j < 4; ++j) { *(u32x4*)(lds + (kr + 8 * j) * AT_KLD + kc) = gk[j]; *(uint2*)(lds + 32 * AT_KLD + (vr + 16 * j) * AT_VLD + vc) = make_uint2(gv[j][0], gv[j][1]); *(uint2*)(lds + 32 * AT_KLD + (vr + 16 * j) * AT_VLD + vc + 4) = make_uint2(gv[j][2], gv[j][3]); }
  }
  for (int i = 0; i < nblk; ++i) {
    u16* cur = lds + (i & 1) * AT_BUF;
    u16* nxt = lds + ((i + 1) & 1) * AT_BUF;
    const bool more = i + 1 < nblk;
    if (more) {
      const u16 *kb, *vb;
      pf(i + 1, kb, vb);
#pragma unroll
      for (int j = 0; j < 4; ++j) { gk[j] = *(const u32x4*)(kb + (size_t)(kr + 8 * j) * ZW + kc); gv[j] = *(const u32x4*)(vb + (size_t)(vr + 16 * j) * TOKS + vc); }
    }
    bf16x8 kf[4], vf[4];
#pragma unroll
    for (int ks = 0; ks < 4; ++ks) kf[ks] = *(const bf16x8*)(cur + r * AT_KLD + ks * 16 + h * 8);
#pragma unroll
    for (int s2 = 0; s2 < 2; ++s2) {
      union { uint2 u[2]; bf16x8 v; } va, vb2;
      const u16* v0 = cur + 32 * AT_KLD + r * AT_VLD + 16 * s2 + 4 * h;
      va.u[0] = *(const uint2*)(v0); va.u[1] = *(const uint2*)(v0 + 8);
      vb2.u[0] = *(const uint2*)(v0 + 32 * AT_VLD); vb2.u[1] = *(const uint2*)(v0 + 32 * AT_VLD + 8);
      vf[2 * s2] = va.v; vf[2 * s2 + 1] = vb2.v;
    }
    attn_compute(S, qf, kf, vf, [&](int e, float s) { return sf(i, e, s); });
    if (more) {
#pragma unroll
      for (int j = 0; j < 4; ++j) { *(u32x4*)(nxt + (kr + 8 * j) * AT_KLD + kc) = gk[j]; *(uint2*)(nxt + 32 * AT_KLD + (vr + 16 * j) * AT_VLD + vc) = make_uint2(gv[j][0], gv[j][1]); *(uint2*)(nxt + 32 * AT_KLD + (vr + 16 * j) * AT_VLD + vc + 4) = make_uint2(gv[j][2], gv[j][3]); }
    }
  }
}
DI void attn_finish(AttnSt& S, bool has_sink, float sink, u16* __restrict__ dst  ) {
  const int h = (tidx() & 63) >> 5;
  float l = S.l + __shfl_xor(S.l, 32);
  float scale;
  if (has_sink) { float mf = fmaxf(S.m, sink); float e = __expf(S.m - mf); l = l * e + __expf(sink - mf); scale = e / l; }
  else scale = 1.f / l;
#pragma unroll
  for (int g = 0; g < 4; ++g) {
    uint2 o;
    o.x = pack2(S.o0[4 * g] * scale, S.o0[4 * g + 1] * scale); o.y = pack2(S.o0[4 * g + 2] * scale, S.o0[4 * g + 3] * scale);
    *(uint2*)(dst + 8 * g + 4 * h) = o;
    o.x = pack2(S.o1[4 * g] * scale, S.o1[4 * g + 1] * scale); o.y = pack2(S.o1[4 * g + 2] * scale, S.o1[4 * g + 3] * scale);
    *(uint2*)(dst + 32 + 8 * g + 4 * h) = o;
  }
}
DI void load_q(bf16x8 (&qf)[4], const u16* __restrict__ qp) {
#pragma unroll
  for (int ks = 0; ks < 4; ++ks) qf[ks] = *(const bf16x8*)(qp + ks * 16);
}
DI void na_item(const Params& p, int l, int item, u16* lds) {
  const int lane = tidx() & 63, r = lane & 31, h = lane >> 5;
  const int half = item & 1, gr = (item >> 1) & 63, hd = (item >> 7) & 3, b = item >> 9;
  const u16* Z = (const u16*)(p.ws + OFF_ZMIX);
  const u16* vt_head = (const u16*)(p.ws + OFF_VTNA) + (size_t)(b * 256 + hd * 64) * TOKS;
  const int qc = half * 32 + r, qrow = b * 4096 + gr * 64 + qc;
  bf16x8 qf[4];
  load_q(qf, Z + (size_t)qrow * ZW + 256 + hd * 64 + h * 8);
  AttnSt S; attn_init(S);
  const int row0 = min(max(gr - 4, 0), 56);
  const int cs = min(max(qc - 8, 0), 48);
  const float* rpb = p.in[25] + (size_t)(l * 4 + hd) * 15 * 31 + (row0 - gr + 7) * 31 + 15 - qc;
  const u16* kcolb = Z + 512 + hd * 64;
  attn_run(S, qf, 24,
    [&](int i, const u16*& kb, const u16*& vb) {
      const int tok0 = i < 16 ? (row0 + (i >> 1)) * 64 + (i & 1) * 32 : 4096 + (i - 16) * 32;
      const int krow = i < 16 ? b * 4096 + tok0 : NLAT + b * 256 + (i - 16) * 32;
      kb = kcolb + (size_t)krow * ZW; vb = vt_head + tok0;
    },
    [&](int i, int e, float s) {
      if (i >= 16) return s;
      const int kc2 = (i & 1) * 32 + crow(e, h);
      const bool ok = kc2 >= cs && kc2 < cs + 16;
      return ok ? s + rpb[(i >> 1) * 31 + kc2] : -1e30f;
    }, lds);
  attn_finish(S, false, 0.f, (u16*)(p.ws + OFF_BR) + (size_t)qrow * D + 512 + hd * 64);
}
DI void sw_item(const Params& p, int l, int item, u16* lds) {
  const int lane = tidx() & 63, r = lane & 31, h = lane >> 5;
  const int qt = item & 127, qh = (item >> 7) & 3, b = item >> 9, kvh = qh >> 1;
  const u16* Z = (const u16*)(p.ws + OFF_ZMIX);
  const u16* vt_head = (const u16*)(p.ws + OFF_VTSW) + (size_t)(b * 128 + kvh * 64) * TOKS;
  const int qpos = qt * 32 + r, qrow = b * 4096 + qpos;
  bf16x8 qf[4];
  load_q(qf, Z + (size_t)qrow * ZW + 768 + qh * 64 + h * 8);
  AttnSt S; attn_init(S);
  const int kb_lo = max(qt - 4, 0), kb_hi = min(qt + 4, 127), nl = kb_hi - kb_lo + 1;
  const u16* kcolb = Z + 1024 + kvh * 64;
  attn_run(S, qf, nl + 8,
    [&](int i, const u16*& kb, const u16*& vb) {
      const int tok0 = i < nl ? (kb_lo + i) * 32 : 4096 + (i - nl) * 32;
      const int krow = i < nl ? b * 4096 + tok0 : NLAT + b * 256 + (i - nl) * 32;
      kb = kcolb + (size_t)krow * ZW; vb = vt_head + tok0;
    },
    [&](int i, int e, float s) {
      if (i >= nl) return s;
      const int d = (kb_lo + i) * 32 + crow(e, h) - qpos;
      return (d <= 128 && d >= -128) ? s : -1e30f;
    }, lds);
  attn_finish(S, true, p.in[26][l * 4 + qh], (u16*)(p.ws + OFF_BR) + (size_t)qrow * D + 768 + qh * 64);
}
DI void ctxattn_item(const Params& p, int l, int item, u16* lds) {
  const int lane = tidx() & 63, r = lane & 31, h = lane >> 5;
  const int qt = item & 7, hd = (item >> 3) & 3, b = (item >> 5) & 3, which = item >> 7;
  const u16* Z = (const u16*)(p.ws + OFF_ZMIX);
  const int qrow = NLAT + b * 256 + qt * 32 + r;
  const int kvh = hd >> 1;
  const int qcol = which == 0 ? 256 + hd * 64 : 768 + hd * 64, kcol = which == 0 ? 512 + hd * 64 : 1024 + kvh * 64;
  const u16* vt_head = which == 0 ? (const u16*)(p.ws + OFF_VTNA) + (size_t)(b * 256 + hd * 64) * TOKS
                                  : (const u16*)(p.ws + OFF_VTSW) + (size_t)(b * 128 + kvh * 64) * TOKS;
  bf16x8 qf[4];
  AttnSt S; attn_init(S);
  load_q(qf, Z + (size_t)qrow * ZW + qcol + h * 8);
  const u16* kcolb = Z + (size_t)(NLAT + b * 256) * ZW + kcol;
  attn_run(S, qf, 8,
    [&](int i, const u16*& kb, const u16*& vb) { kb = kcolb + (size_t)(i * 32) * ZW; vb = vt_head + 4096 + i * 32; },
    [&](int, int, float s) { return s; }, lds);
  attn_finish(S, which == 1, p.in[26][l * 4 + hd], (u16*)(p.ws + OFF_BR) + (size_t)qrow * D + (which == 0 ? 512 : 768) + hd * 64);
}

DI int s5_chunk_row0(int b, int cc) { return cc < 4 ? NLAT + b * 256 + cc * 64 : b * 4096 + (cc - 4) * 64; }
DI void s5_passA_item(const Params& p, int item, float* su  ) {
  const int lane = tidx() & 63;
  const int cc = item % NCHUNK; int t = item / NCHUNK; const int g = t & 15; t >>= 4; const int b = t & 3, dir = t >> 2;
  const u16* Z = (const u16*)(p.ws + OFF_ZMIX);
  const int row0 = s5_chunk_row0(b, cc);
  {
    const u16* src = Z + (size_t)(row0 + lane) * ZW + g * 16;
    uint4 q0 = *(const uint4*)src, q1 = *(const uint4*)(src + 8);
    unsigned uu[8] = {q0.x, q0.y, q0.z, q0.w, q1.x, q1.y, q1.z, q1.w};
#pragma unroll
    for (int j = 0; j < 8; ++j) { su[lane * 16 + 2 * j] = __uint_as_float(uu[j] << 16); su[lane * 16 + 2 * j + 1] = __uint_as_float(uu[j] & 0xffff0000u); }
  }
  __builtin_amdgcn_wave_barrier();
  __threadfence_block();
  const int si = (dir * 16 + g) * 64 + lane;
  const float* A = (const float*)(p.ws + OFF_S5A);
  const float are = A[si * 2], aim = A[si * 2 + 1];
  float bbr[16], bbi[16];
  {
    const float4* BB = (const float4*)((const float*)(p.ws + OFF_S5BB) + (size_t)si * 32);
#pragma unroll
    for (int j = 0; j < 8; ++j) { float4 q = BB[j]; bbr[2 * j] = q.x; bbi[2 * j] = q.y; bbr[2 * j + 1] = q.z; bbi[2 * j + 1] = q.w; }
  }
  float hr = 0.f, hi = 0.f;
  for (int i = 0; i < 64; ++i) {
    const int tt = dir ? 63 - i : i;
    float ur = 0.f, ui = 0.f;
#pragma unroll
    for (int q = 0; q < 4; ++q) {
      float4 u4 = *(const float4*)(su + tt * 16 + q * 4);
      ur += bbr[q * 4] * u4.x + bbr[q * 4 + 1] * u4.y + bbr[q * 4 + 2] * u4.z + bbr[q * 4 + 3] * u4.w;
      ui += bbi[q * 4] * u4.x + bbi[q * 4 + 1] * u4.y + bbi[q * 4 + 2] * u4.z + bbi[q * 4 + 3] * u4.w;
    }
    float nr = are * hr - aim * hi + ur, ni = are * hi + aim * hr + ui;
    hr = nr; hi = ni;
  }
  float* So = (float*)(p.ws + OFF_S5S) + ((((size_t)(dir * 4 + b) * NCHUNK + cc) * 16 + g) * 64 + lane) * 2;
  So[0] = hr; So[1] = hi;
  __builtin_amdgcn_wave_barrier();
}
DI void s5_passB_thread(const Params& p, int i) {
  const int pp = i & 63, g = (i >> 6) & 15, b = (i >> 10) & 3, dir = i >> 12;
  const float* A = (const float*)(p.ws + OFF_S5A);
  const int si = (dir * 16 + g) * 64 + pp;
  float ar = A[si * 2], ai = A[si * 2 + 1];
  for (int k = 0; k < 6; ++k) { float nr = ar * ar - ai * ai, ni = 2.f * ar * ai; ar = nr; ai = ni; }
  const float* S = (const float*)(p.ws + OFF_S5S);
  float hr = 0.f, hi = 0.f;
  asm volatile("" : "+v"(hr), "+v"(hi));
  for (int k0 = 0; k0 < NCHUNK; k0 += 17) {
    float2 sv[17];
#pragma unroll
    for (int j = 0; j < 17; ++j) {
      const int k = k0 + j;
      const int cc = dir == 0 ? k : (k < 4 ? 3 - k : NCHUNK + 3 - k);
      sv[j] = *(const float2*)(S + ((((size_t)(dir * 4 + b) * NCHUNK + cc) * 16 + g) * 64 + pp) * 2);
    }
#pragma unroll
    for (int j = 0; j < 17; ++j) {
      const int k = k0 + j;
      const int cc = dir == 0 ? k : (k < 4 ? 3 - k : NCHUNK + 3 - k);
      *(unsigned*)((u16*)(p.ws + OFF_HB) + ((size_t)g * NCOL + b * NCHUNK + cc) * 256 + dir * 128 + pp * 2) = pack2(hr, hi);
      float nr = ar * hr - ai * hi + sv[j].x, ni = ar * hi + ai * hr + sv[j].y;
      hr = nr; hi = ni;
    }
  }
}
DI void s5_passC_item(const Params& p, int l, int b, int g, int cc, char* smem) {
  const int tid = tidx();
  float* su = (float*)smem;
  float* ys = su + 1024;
  float* cre = ys + 1024;
  float* cim = cre + 2 * 16 * 65;
  float* hre = cim + 2 * 16 * 65;
  float* him = hre + 2 * 16 * 65;
  const u16* Z = (const u16*)(p.ws + OFF_ZMIX);
  const int row0 = s5_chunk_row0(b, cc);
  for (int e = tid; e < 1024; e += 256) { su[e] = bf2f(Z[(size_t)(row0 + (e >> 4)) * ZW + g * 16 + (e & 15)]); ys[e] = 0.f; }
  for (int e = tid; e < 2048; e += 256) {
    int dir = e >> 10, n = (e >> 6) & 15, pp = e & 63;
    size_t gi = ((((size_t)l * 2 + dir) * 16 + g) * 16 + n) * 64 + pp;
    cre[(dir * 16 + n) * 65 + pp] = p.in[12][gi];
    cim[(dir * 16 + n) * 65 + pp] = p.in[13][gi];
  }
  __syncthreads();
  float are = 0, aim = 0, hr = 0, hi = 0;
  float bbr[16], bbi[16];
  const int sdir = (tid >> 6) & 1, spp = tid & 63;
  if (tid < 128) {
    const int si = (sdir * 16 + g) * 64 + spp;
    const float* A = (const float*)(p.ws + OFF_S5A);
    are = A[si * 2]; aim = A[si * 2 + 1];
    const float4* BB = (const float4*)((const float*)(p.ws + OFF_S5BB) + (size_t)si * 32);
#pragma unroll
    for (int j = 0; j < 8; ++j) { float4 q = BB[j]; bbr[2 * j] = q.x; bbi[2 * j] = q.y; bbr[2 * j + 1] = q.z; bbi[2 * j + 1] = q.w; }
    const float* Hh = (const float*)(p.ws + OFF_S5H) + ((((size_t)(sdir * 4 + b) * NCHUNK + cc) * 16 + g) * 64 + spp) * 2;
    hr = Hh[0]; hi = Hh[1];
  } else {
#pragma unroll
    for (int j = 0; j < 16; ++j) { bbr[j] = 0.f; bbi[j] = 0.f; }
  }
  for (int sub = 0; sub < 4; ++sub) {
    if (tid < 128) {
      for (int i = 0; i < 16; ++i) {
        const int tt = sdir ? 63 - (sub * 16 + i) : sub * 16 + i;
        float ur = 0.f, ui = 0.f;
#pragma unroll
        for (int q = 0; q < 4; ++q) {
          float4 u4 = *(const float4*)(su + tt * 16 + q * 4);
          ur += bbr[q * 4] * u4.x + bbr[q * 4 + 1] * u4.y + bbr[q * 4 + 2] * u4.z + bbr[q * 4 + 3] * u4.w;
          ui += bbi[q * 4] * u4.x + bbi[q * 4 + 1] * u4.y + bbi[q * 4 + 2] * u4.z + bbi[q * 4 + 3] * u4.w;
        }
        float nr = are * hr - aim * hi + ur, ni = are * hi + aim * hr + ui;
        hr = nr; hi = ni;
        hre[(sdir * 16 + i) * 65 + spp] = hr;
        him[(sdir * 16 + i) * 65 + spp] = hi;
      }
    }
    __syncthreads();
    {
      const int dir = tid >> 7, i = (tid >> 3) & 15, n = tid & 7;
      const float* hrp = hre + (dir * 16 + i) * 65;
      const float* hip_ = him + (dir * 16 + i) * 65;
      const float* c0r = cre + (dir * 16 + n) * 65;
      const float* c0i = cim + (dir * 16 + n) * 65;
      const float* c1r = c0r + 8 * 65;
      const float* c1i = c0i + 8 * 65;
      float y0 = 0.f, y1 = 0.f;
#pragma unroll 8
      for (int pp = 0; pp < 64; ++pp) {
        float a = hrp[pp], bq = hip_[pp];
        y0 += c0r[pp] * a - c0i[pp] * bq;
        y1 += c1r[pp] * a - c1i[pp] * bq;
      }
      const int tt = dir ? 63 - (sub * 16 + i) : sub * 16 + i;
      ys[tt * 16 + n] += y0;
      ys[tt * 16 + n + 8] += y1;
    }
    __syncthreads();
  }
  const float* dd = p.in[14] + l * 256 + g * 16;
  u16* G = (u16*)(p.ws + OFF_S5G);
  for (int e = tid; e < 1024; e += 256) {
    int tt = e >> 4, n = e & 15;
    float y = ys[e] + dd[n] * su[e];
    G[(size_t)(row0 + tt) * 256 + g * 16 + n] = f2bf(gelu_tanh(y));
  }
  __syncthreads();
}


DI void s5_disc_compute(const Params& p, int l, int si  , float& lm, float& th, float& f_re, float& f_im) {
  const int dir = si >> 10, g = (si >> 6) & 15;
  const float lre = p.in[7][l * 2048 + si], lim = p.in[8][l * 2048 + si];
  const float dt = __expf(p.in[9][(l * 2 + dir) * 16 + g]);
  lm = lre * dt; th = lim * dt;
  float sn, cs; sincosf(th, &sn, &cs);
  const float em1 = expm1f(lm), mag = em1 + 1.f;
  const float a_im = mag * sn;
  const float sh = sinf(0.5f * th);
  const float are_m1 = em1 * cs - 2.f * sh * sh;
  const float den = lre * lre + lim * lim;
  f_re = (are_m1 * lre + a_im * lim) / den; f_im = (a_im * lre - are_m1 * lim) / den;
}
DI void s5_disc(const Params& p, int l, int si, float& lm, float& th, float& f_re, float& f_im) {
  const float4 v = *(const float4*)((const float*)(p.ws + OFF_S5D) + ((size_t)l * 2048 + si) * 4);
  lm = v.x; th = v.y; f_re = v.z; f_im = v.w;
}
DI void s5_cpow(float lm, float th, int k, float& re, float& im) {
  const float x = th * (float)k;
  const float sn = __sinf(x), cs = __cosf(x);
  const float mg = __expf(lm * (float)k);
  re = mg * cs; im = mg * sn;
}
DI void s5_k2_thread(const Params& p, int l, int idx) {
  const int tb = idx & 7, m = (idx >> 3) & 15, n = (idx >> 7) & 15, d = (idx >> 11) & 1, g = idx >> 12;
  float acc[8];
#pragma unroll
  for (int e = 0; e < 8; ++e) acc[e] = 0.f;
  float extra = 0.f;
  for (int pp = 0; pp < 64; ++pp) {
    const int si = (d * 16 + g) * 64 + pp;
    float lm, th, fr, fi; s5_disc(p, l, si, lm, th, fr, fi);
    const float br = p.in[10][((size_t)l * 2048 + si) * 16 + m], bi = p.in[11][((size_t)l * 2048 + si) * 16 + m];
    const float bbr = fr * br - fi * bi, bbi = fr * bi + fi * br;
    const size_t ci = ((((size_t)l * 2 + d) * 16 + g) * 16 + n) * 64 + pp;
    const float cr = p.in[12][ci], cim = p.in[13][ci];
    float wr = cr * bbr - cim * bbi, wi = cr * bbi + cim * bbr;
    float pr, pi; s5_cpow(lm, th, tb * 8, pr, pi);
    float ar, ai; s5_cpow(lm, th, 1, ar, ai);
    float xr = wr * pr - wi * pi, xi = wr * pi + wi * pr;
#pragma unroll
    for (int e = 0; e < 8; ++e) { acc[e] += xr; float nr = xr * ar - xi * ai, ni = xr * ai + xi * ar; xr = nr; xi = ni; }
    if (d == 0 && tb == 0) {
      const int s1 = (16 + g) * 64 + pp;
      float lm1, th1, fr1, fi1; s5_disc(p, l, s1, lm1, th1, fr1, fi1);
      const float br1 = p.in[10][((size_t)l * 2048 + s1) * 16 + m], bi1 = p.in[11][((size_t)l * 2048 + s1) * 16 + m];
      const float b1r = fr1 * br1 - fi1 * bi1, b1i = fr1 * bi1 + fi1 * br1;
      const size_t c1 = ((((size_t)l * 2 + 1) * 16 + g) * 16 + n) * 64 + pp;
      extra += p.in[12][c1] * b1r - p.in[13][c1] * b1i;
    }
  }
  u16* K2 = (u16*)(p.ws + OFF_K2) + (size_t)g * 127 * 256 + n * 16 + m;
  if (d == 0 && tb == 0) acc[0] += extra + (n == m ? p.in[14][l * 256 + g * 16 + n] : 0.f);
#pragma unroll
  for (int e = 0; e < 8; ++e) {
    const int k = tb * 8 + e;
    if (d == 0) K2[(size_t)(63 + k) * 256] = f2bf(acc[e]);
    else if (k > 0) K2[(size_t)(63 - k) * 256] = f2bf(acc[e]);
  }
}
DI void s5_pe_thread(const Params& p, int l, int idx) {
  const int sx = idx & 63, pp = (idx >> 6) & 63, d = (idx >> 12) & 1, g = idx >> 13;
  const int si = (d * 16 + g) * 64 + pp;
  float lm, th, fr, fi; s5_disc(p, l, si, lm, th, fr, fi);
  float qr, qi; s5_cpow(lm, th, d == 0 ? 63 - sx : sx, qr, qi);
  u16* P0 = (u16*)(p.ws + OFF_PT) + ((size_t)g * 256 + d * 128 + pp * 2) * 1024 + sx * 16;
  const float* bre = p.in[10] + ((size_t)l * 2048 + si) * 16;
  const float* bim = p.in[11] + ((size_t)l * 2048 + si) * 16;
  unsigned pr_[8], pi_[8];
#pragma unroll
  for (int m2 = 0; m2 < 8; ++m2) {
    float vr[2], vi[2];
#pragma unroll
    for (int q = 0; q < 2; ++q) {
      const float br = bre[2 * m2 + q], bi = bim[2 * m2 + q];
      const float bbr = fr * br - fi * bi, bbi = fr * bi + fi * br;
      vr[q] = qr * bbr - qi * bbi; vi[q] = qr * bbi + qi * bbr;
    }
    pr_[m2] = pack2(vr[0], vr[1]); pi_[m2] = pack2(vi[0], vi[1]);
  }
  *(uint4*)(P0) = make_uint4(pr_[0], pr_[1], pr_[2], pr_[3]); *(uint4*)(P0 + 8) = make_uint4(pr_[4], pr_[5], pr_[6], pr_[7]);
  *(uint4*)(P0 + 1024) = make_uint4(pi_[0], pi_[1], pi_[2], pi_[3]); *(uint4*)(P0 + 1024 + 8) = make_uint4(pi_[4], pi_[5], pi_[6], pi_[7]);
  float er, ei; s5_cpow(lm, th, d == 0 ? sx + 1 : 64 - sx, er, ei);
  u16* E0 = (u16*)(p.ws + OFF_ET) + ((size_t)g * 1024 + sx * 16) * 256 + d * 128 + pp * 2;
#pragma unroll
  for (int n = 0; n < 16; ++n) {
    const size_t ci = ((((size_t)l * 2 + d) * 16 + g) * 16 + n) * 64 + pp;
    const float cr = p.in[12][ci], cim = p.in[13][ci];
    *(unsigned*)(E0 + (size_t)n * 256) = pack2(cr * er - cim * ei, -(cr * ei + cim * er));
  }
}
DI int s5_col_row0(int col) { const int b = col / NCHUNK, cc = col - b * NCHUNK; return cc < 4 ? NLAT + b * 256 + cc * 64 : b * 4096 + (cc - 4) * 64; }
struct S5UFn {
  const u16* base[2];
  DI S5UFn(const Params& p, int g, int n0) {
    const int tid = tidx(), lrow = tid >> 3, lch = tid & 7;
#pragma unroll
    for (int i = 0; i < 2; ++i) {
      const int col = min(n0 + lrow + 32 * i, NCOL - 1);
      base[i] = (const u16*)(p.ws + OFF_ZMIX) + (size_t)(s5_col_row0(col) + (lch >> 1)) * ZW + g * 16 + (lch & 1) * 8;
    }
  }
  DI const u16* operator()(int i, int kt) const { return base[i] + (size_t)kt * 4 * ZW; }
};
DI void s5_state_tile(const Params& p, int g, int mt, int nt, char* smem) {
  const int tid = tidx(), lane = tid & 63, w = tid >> 6, r = lane & 31, h = lane >> 5, lrow = tid >> 3, lch = tid & 7;
  const int m0 = mt * 128, n0 = nt * 64;
  f32x16 acc[2][1]; zero_acc<1>(acc);
  const u16* ga = (const u16*)(p.ws + OFF_PT) + ((size_t)g * 256 + m0 + lrow) * 1024 + lch * 8;
  S5UFn fb(p, g, n0);
  gemm_acc_f<1>([=](int i, int kt) { return ga + (size_t)i * 32 * 1024 + kt * 64; }, fb, 16, acc, (u16*)smem);
  float* S = (float*)(p.ws + OFF_S5S);
  const int col = n0 + (w & 1) * 32 + r;
  if (col < NCOL) {
#pragma unroll
    for (int a = 0; a < 2; ++a)
#pragma unroll
      for (int i = 0; i < 16; ++i) {
        const int dpr = m0 + (w >> 1) * 64 + a * 32 + crow(i, h);
        S[(((size_t)(dpr >> 7) * NCOL + col) * 16 + g) * 128 + (dpr & 127)] = acc[a][0][i];
      }
  }
}
DI void s5_out_tile(const Params& p, int g, int mt, int nt, char* smem) {
  const int tid = tidx(), lane = tid & 63, w = tid >> 6, r = lane & 31, h = lane >> 5, lrow = tid >> 3, lch = tid & 7;
  const int m0 = mt * 128, n0 = nt * 64;
  f32x16 acc[2][1]; zero_acc<1>(acc);
  S5UFn fb(p, g, n0);
  {
    const u16* k2 = (const u16*)(p.ws + OFF_K2) + (size_t)g * 127 * 256 + (lch & 1) * 8;
    const int rr = m0 + lrow, t0 = rr >> 4, n = rr & 15;
    const u16* ka = k2 + ((size_t)(t0 - (lch >> 1) + 63) * 16 + n) * 16;
    gemm_acc_f<1>([=](int i, int kt) { return ka + (ptrdiff_t)(2 * i - 4 * kt) * 256; }, fb, 16, acc, (u16*)smem);
  }
  {
    const u16* ga = (const u16*)(p.ws + OFF_ET) + ((size_t)g * 1024 + m0 + lrow) * 256 + lch * 8;
    const u16* hb = (const u16*)(p.ws + OFF_HB) + (size_t)g * NCOL * 256 + lch * 8;
    const int c0 = min(n0 + lrow, NCOL - 1), c1 = min(n0 + lrow + 32, NCOL - 1);
    const u16* gb0 = hb + (size_t)c0 * 256;
    const u16* gb1 = hb + (size_t)c1 * 256;
    gemm_acc_f<1>([=](int i, int kt) { return ga + (size_t)i * 32 * 256 + kt * 64; },
                  [=](int i, int kt) { return (i == 0 ? gb0 : gb1) + kt * 64; }, 4, acc, (u16*)smem);
  }
  const int col = n0 + (w & 1) * 32 + r;
  if (col < NCOL) {
    u16* G = (u16*)(p.ws + OFF_S5G) + (size_t)s5_col_row0(col) * 256 + g * 16;
#pragma unroll
    for (int a = 0; a < 2; ++a)
#pragma unroll
      for (int q = 0; q < 4; ++q) {
        const int tn = m0 + (w >> 1) * 64 + a * 32 + 8 * q + 4 * h;
        uint2 o;
        o.x = pack2(gelu_tanh(acc[a][0][4 * q]), gelu_tanh(acc[a][0][4 * q + 1]));
        o.y = pack2(gelu_tanh(acc[a][0][4 * q + 2]), gelu_tanh(acc[a][0][4 * q + 3]));
        *(uint2*)(G + (size_t)(tn >> 4) * 256 + (tn & 15)) = o;
      }
  }
}

constexpr int HY_E = 0, HY_O = 16384 + 64, HY_U = 32896;
DI void hyena_mfma_item(const Params& p, int l, int order, int c, int half, char* smem) {
  const int tid = tidx(), lane = tid & 63, w = tid >> 6, r = lane & 31, h = lane >> 5;
  {
    const u16* FR = (const u16*)(p.ws + OFF_FILTR) + ((size_t)order * 256 + c) * 8192;
#pragma unroll
    for (int ci = tid; ci < 1024; ci += 256) {
      uint4 q = *(const uint4*)(FR + ci * 8);
      unsigned nx = ci < 1023 ? *(const unsigned*)(FR + ci * 8 + 8) : 0u;
      *(uint4*)(smem + HY_E + ci * 16) = q;
      uint4 o; o.x = (q.x >> 16) | (q.y << 16); o.y = (q.y >> 16) | (q.z << 16); o.z = (q.z >> 16) | (q.w << 16); o.w = (q.w >> 16) | (nx << 16);
      *(uint4*)(smem + HY_O + ci * 16) = o;
    }
  }
  {
    unsigned zz = 0;
    asm volatile("" : "+v"(zz));
    for (int e = tid; e < 448; e += 256) {
      int J = e >> 3; int Jb = J < 28 ? J : J + 256;
      *(uint4*)(smem + HY_U + Jb * 128 + (e & 7) * 16) = make_uint4(zz, zz, zz, zz);
    }
  }
  const float* cw = p.in[16] + (size_t)l * 3 * 768;
  const float* cb = p.in[17] + (size_t)l * 768;
  {
    const float w0 = cw[c], w1 = cw[768 + c], w2 = cw[1536 + c], wb = cb[c];
#pragma unroll
    for (int e = tid; e < 2048; e += 256) {
      const int b = e >> 9, ch = e & 511, t0 = ch * 8;
      uint4 val;
      if (order == 0) {
        const u16* src = (const u16*)(p.ws + OFF_HYT) + ((size_t)(b * 768 + c)) * TOKS;
        uint4 q = *(const uint4*)(src + t0);
        float z[10];
        z[0] = t0 > 0 ? bf2f(src[t0 - 1]) : 0.f;
        z[9] = t0 + 8 < 4096 ? bf2f(src[t0 + 8]) : 0.f;
        unsigned uu[4] = {q.x, q.y, q.z, q.w};
#pragma unroll
        for (int k = 0; k < 4; ++k) { z[1 + 2 * k] = __uint_as_float(uu[k] << 16); z[2 + 2 * k] = __uint_as_float(uu[k] & 0xffff0000u); }
        float u[8];
#pragma unroll
        for (int k = 0; k < 8; ++k) u[k] = w0 * z[k] + w1 * z[k + 1] + w2 * z[k + 2] + wb;
        val.x = pack2(u[0], u[1]); val.y = pack2(u[2], u[3]); val.z = pack2(u[4], u[5]); val.w = pack2(u[6], u[7]);
      } else {
        val = *(const uint4*)((const u16*)(p.ws + OFF_HYV1) + ((size_t)(b * 256 + c)) * TOKS + t0);
      }
      const int J = ((ch >> 3) + 7) * 4 + b, q8 = ch & 7;
      *(uint4*)(smem + HY_U + J * 128 + ((q8 ^ ((J >> 1) & 7)) << 4)) = val;
    }
  }
  __syncthreads();
  const int i0 = half * 32 + w * 8, il = r >> 2, bt = r & 3;
  f32x16 acc0, acc1;
#pragma unroll
  for (int i = 0; i < 16; ++i) { acc0[i] = 0.f; acc1[i] = 0.f; }
  const int fbase = ((r & 1) ? HY_E + ((4095 - r) >> 1) * 4 : HY_O + ((4094 - r) >> 1) * 4) + h * 16;
  for (int d = i0 - 63; d <= i0 + 7; ++d) {
    const int J = (i0 + il - d + 7) * 4 + bt;
    const char* ub = smem + HY_U + J * 128;
    const int key = (J >> 1) & 7;
    const char* fb = smem + fbase - 128 * d;
    bf16x8 fr[6];
#pragma unroll
    for (int k = 0; k < 6; ++k) {
      const unsigned* q = (const unsigned*)(fb - 32 * (k - 3));
      union { unsigned u[4]; bf16x8 v; } t;
      t.u[0] = q[0]; t.u[1] = q[1]; t.u[2] = q[2]; t.u[3] = q[3];
      fr[k] = t.v;
    }
#pragma unroll
    for (int ks = 0; ks < 4; ++ks) {
      bf16x8 bf = *(const bf16x8*)(ub + (((2 * ks + h) ^ key) << 4));
      acc0 = MFMA32(fr[3 - ks], bf, acc0);
      acc1 = MFMA32(fr[5 - ks], bf, acc1);
    }
  }
  const int gc = (order + 1) * 256 + c;
  const float g0 = cw[gc], g1 = cw[768 + gc], g2 = cw[1536 + gc], gb = cb[gc];
  const u16* zs = (const u16*)(p.ws + OFF_HYT) + ((size_t)(bt * 768 + gc)) * TOKS;
  u16* dst = (u16*)(p.ws + (order == 0 ? OFF_HYV1 : OFF_HYO)) + ((size_t)(bt * 256 + c)) * TOKS;
#pragma unroll
  for (int m = 0; m < 2; ++m)
#pragma unroll
    for (int g = 0; g < 4; ++g) {
      const int t = 64 * (i0 + il) + 32 * m + 8 * g + 4 * h;
      uint2 q = *(const uint2*)(zs + t);
      float z[6];
      z[0] = t > 0 ? bf2f(zs[t - 1]) : 0.f;
      z[5] = t + 4 < 4096 ? bf2f(zs[t + 4]) : 0.f;
      z[1] = __uint_as_float(q.x << 16); z[2] = __uint_as_float(q.x & 0xffff0000u);
      z[3] = __uint_as_float(q.y << 16); z[4] = __uint_as_float(q.y & 0xffff0000u);
      float o[4];
#pragma unroll
      for (int k = 0; k < 4; ++k) {
        float gate = g0 * z[k] + g1 * z[k + 1] + g2 * z[k + 2] + gb;
        o[k] = gate * (m == 0 ? acc0[4 * g + k] : acc1[4 * g + k]);
      }
      uint2 ov; ov.x = pack2(o[0], o[1]); ov.y = pack2(o[2], o[3]);
      *(uint2*)(dst + t) = ov;
    }
  __syncthreads();
}
DI void hyena_ctx_item(const Params& p, int l, int order, int b, int c, char* smem) {
  const int t = tidx();
  float* su = (float*)smem;
  float* sk = su + 256;
  const float* cw = p.in[16] + (size_t)l * 3 * 768;
  const float* cb = p.in[17] + (size_t)l * 768;
  const u16* zv = (const u16*)(p.ws + OFF_HYT) + ((size_t)(b * 768 + c)) * TOKS + 4096;
  if (order == 0) {
    float zl = t > 0 ? bf2f(zv[t - 1]) : 0.f, zc = bf2f(zv[t]), zr = t < 255 ? bf2f(zv[t + 1]) : 0.f;
    su[t] = bf2f(f2bf(cw[c] * zl + cw[768 + c] * zc + cw[1536 + c] * zr + cb[c]));
  } else {
    su[t] = bf2f(((const u16*)(p.ws + OFF_HYV1))[((size_t)(b * 256 + c)) * TOKS + 4096 + t]);
  }
  const float* FC = (const float*)(p.ws + OFF_FCTX) + ((size_t)order * 256 + c) * 512;
  sk[t] = t > 0 ? FC[t] : 0.f;
  sk[256 + t] = FC[256 + t];
  __syncthreads();
  float acc = 0.f;
#pragma unroll 8
  for (int s = 0; s < 256; ++s) acc += sk[t - s + 256] * su[s];
  const int gc = (order + 1) * 256 + c;
  const u16* zg = (const u16*)(p.ws + OFF_HYT) + ((size_t)(b * 768 + gc)) * TOKS + 4096;
  float zl = t > 0 ? bf2f(zg[t - 1]) : 0.f, zc = bf2f(zg[t]), zr = t < 255 ? bf2f(zg[t + 1]) : 0.f;
  float gate = cw[gc] * zl + cw[768 + gc] * zc + cw[1536 + gc] * zr + cb[gc];
  u16* dst = (u16*)(p.ws + (order == 0 ? OFF_HYV1 : OFF_HYO)) + ((size_t)(b * 256 + c)) * TOKS + 4096;
  dst[t] = f2bf(gate * acc);
  __syncthreads();
}
DI void hyena_transpose_item(const Params& p, int b, int ct, int tt, char* smem) {
  const int tid = tidx();
  u16* tile = (u16*)smem;
  const u16* src = (const u16*)(p.ws + OFF_HYO) + ((size_t)(b * 256 + ct * 64)) * TOKS + tt * 64;
  for (int e = tid; e < 2048; e += 256) {
    int cc = e >> 5, t2 = (e & 31) * 2;
    *(unsigned*)(tile + cc * 66 + t2) = *(const unsigned*)(src + (size_t)cc * TOKS + t2);
  }
  __syncthreads();
  const int rowb = tt < 64 ? b * 4096 + tt * 64 : NLAT + b * 256 + (tt - 64) * 64;
  u16* BR = (u16*)(p.ws + OFF_BR);
  for (int e = tid; e < 2048; e += 256) {
    int tk = e >> 5, c2 = (e & 31) * 2;
    unsigned v = (unsigned)tile[c2 * 66 + tk] | ((unsigned)tile[(c2 + 1) * 66 + tk] << 16);
    *(unsigned*)(BR + (size_t)(rowb + tk) * D + 256 + ct * 64 + c2) = v;
  }
  __syncthreads();
}


template <int NI, class EPI>
DI void for_acc(f32x16 (&acc)[2][NI], int m0, int n0, EPI epi) {
  const int lane = tidx() & 63, w = tidx() >> 6, r = lane & 31, h = lane >> 5;
#pragma unroll
  for (int mi = 0; mi < 2; ++mi)
#pragma unroll
    for (int ni = 0; ni < NI; ++ni)
#pragma unroll
      for (int i = 0; i < 16; ++i) epi(m0 + (w >> 1) * 64 + mi * 32 + crow(i, h), n0 + (w & 1) * 32 * NI + ni * 32 + r, acc[mi][ni][i]);
}
template <int NI>
DI void wout_tile(const Params& p, int l, int m0, int n0, char* smem) {
  f32x16 acc[2][NI]; zero_acc<NI>(acc);
  gemm_acc<NI>((const u16*)(p.ws + OFF_MERGED) + (size_t)m0 * D, D, (const u16*)(p.ws + OFF_WO) + (size_t)n0 * D, D, 1024, acc, (u16*)smem);
  const float* gav = modp(p, l, bidx_of_row(m0), 2);
  float* xo = xrow(p, m0);
  const float* xi = xin_row(p, l, m0);
  for_acc<NI>(acc, 0, n0, [&](int row, int col, float v) {
    xo[(size_t)row * D + col] = ALPHA * xi[(size_t)row * D + col] + gav[col] * v;
  });
}
template <int NI>
DI void mlp2_tile(const Params& p, int l, int m0, int n0, char* smem) {
  f32x16 acc[2][NI]; zero_acc<NI>(acc);
  gemm_acc<NI>((const u16*)(p.ws + OFF_HID) + (size_t)m0 * 4096, 4096, (const u16*)(p.ws + OFF_W2) + (size_t)n0 * 4096, 4096, 4096, acc, (u16*)smem);
  const float* gmv = modp(p, l, bidx_of_row(m0), 5);
  float* xo = xrow(p, m0);
  for_acc<NI>(acc, 0, n0, [&](int row, int col, float v) {
    float* xp = xo + (size_t)row * D + col;
    *xp = ALPHA * (*xp) + gmv[col] * v;
  });
}
template <int NI>
DI void merge_tile(const Params& p, int m0, int n0, char* smem) {
  const u16* H = (const u16*)(p.ws + OFF_H);
  const u16* BR = (const u16*)(p.ws + OFF_BR);
  const u16* WG = (const u16*)(p.ws + OFF_WIN) + (size_t)2304 * D;
  const u16* WB = (const u16*)(p.ws + OFF_WBR);
  u16* M = (u16*)(p.ws + OFF_MERGED);
  unsigned amp[2][NI][8];
#pragma unroll
  for (int a = 0; a < 2; ++a)
#pragma unroll
    for (int b2 = 0; b2 < NI; ++b2)
#pragma unroll
      for (int i = 0; i < 8; ++i) amp[a][b2][i] = 0u;
  for (int nb = 0; nb < 4; ++nb) {
    f32x16 ag[2][NI]; zero_acc<NI>(ag);
    gemm_acc<NI>(H + (size_t)m0 * D, D, WG + (size_t)(nb * 1024 + n0) * D, D, 1024, ag, (u16*)smem);
    unsigned sg[2][NI][8];
#pragma unroll
    for (int a = 0; a < 2; ++a)
#pragma unroll
      for (int b2 = 0; b2 < NI; ++b2)
#pragma unroll
        for (int i = 0; i < 8; ++i) sg[a][b2][i] = pack2(sigmoidf_(ag[a][b2][2 * i]), sigmoidf_(ag[a][b2][2 * i + 1]));
    zero_acc<NI>(ag);
    {
      const int lrow = tidx() >> 3, lch = tidx() & 7;
      const u16* ga = BR + (size_t)(m0 + lrow) * D + nb * 256 + lch * 8;
      const u16* gb = WB + (size_t)(nb * 1024 + n0 + lrow) * 256 + lch * 8;
      gemm_acc_f1<NI>([=](int i, int kt) { return ga + (size_t)i * 32 * D + kt * 64; },
                      [=](int i, int kt) { return gb + (size_t)i * 32 * 256 + kt * 64; }, 4, ag, (u16*)smem);
    }
#pragma unroll
    for (int a = 0; a < 2; ++a)
#pragma unroll
      for (int b2 = 0; b2 < NI; ++b2)
#pragma unroll
        for (int i = 0; i < 8; ++i) {
          const float lo = __uint_as_float(amp[a][b2][i] << 16) + __uint_as_float(sg[a][b2][i] << 16) * ag[a][b2][2 * i];
          const float hi2 = __uint_as_float(amp[a][b2][i] & 0xffff0000u) + __uint_as_float(sg[a][b2][i] & 0xffff0000u) * ag[a][b2][2 * i + 1];
          amp[a][b2][i] = pack2(lo, hi2);
        }
  }
  const int lane = tidx() & 63, w = tidx() >> 6, r = lane & 31, h = lane >> 5;
#pragma unroll
  for (int a = 0; a < 2; ++a)
#pragma unroll
    for (int b2 = 0; b2 < NI; ++b2)
#pragma unroll
      for (int i = 0; i < 8; ++i) {
        const int col = n0 + (w & 1) * 32 * NI + b2 * 32 + r;
        const int row0_ = m0 + (w >> 1) * 64 + a * 32;
        M[(size_t)(row0_ + crow(2 * i, h)) * D + col] = (u16)(amp[a][b2][i] & 0xffffu);
        M[(size_t)(row0_ + crow(2 * i + 1, h)) * D + col] = (u16)(amp[a][b2][i] >> 16);
      }
}
template <class F2, class F1>
DI void n1024_items(bool last, F2 full, F1 half) {
  const int nhalf = last ? 0 : 128;
  const bool swz = gridDim.x == 512;
  for (int it = blockIdx.x; it < 1024 + nhalf; it += gridDim.x) {
    const bool isfull = it < 1024;
    const int b = it & 511, x = b & 7, j = b >> 3;
    int m, n;
    if (swz) { m = isfull ? ((it >> 9) * 8 + x) * 8 + (j >> 3) : 128 + x; n = isfull ? (j & 7) : j; }
    else { m = isfull ? (it >> 3) : 128 + ((it - 1024) >> 4); n = isfull ? (it & 7) : ((it - 1024) & 15); }
    if (isfull) full(m * 128, n * 128); else half(m * 128, n * 64);
  }
}

DI void run_phase(const Params& p0, int ph, char* smem) {
  Params p = p0;
  {
    size_t z = 0;
    asm volatile("" : "+s"(z));
#pragma unroll
    for (int i = 0; i < 35; ++i) p.in[i] = p0.in[i] + z;
    p.out = p0.out + z;
    p.ws = p0.ws + z;
  }
  const int tid = tidx(), w = tid >> 6;
  if (ph == 0) { phase_mod(p, smem); phase_prep(p, 0, smem, true, false, false); return; }
  const int l = (ph - 1) / 12, k = (ph - 1) % 12;
  const bool last = (l == 1);
  const int mtiles = last ? 128 : 136;
  switch (k) {
    case 0: phase_prep(p, l, smem, l != 0, l == 0, true); break;
    case 1: phase_inproj(p, l, smem); break;
    case 2: {
      for (int it = blockIdx.x; it < 160; it += gridDim.x) s5_state_tile(p, it / 10, (it % 10) / 5, it % 5, smem);
      {
        const int nHy = 512 + (last ? 0 : 1024);
        for (int it = blockIdx.x; it < nHy; it += gridDim.x) {
          const int it2 = nHy - 1 - it;
          if (it2 < 512) hyena_mfma_item(p, l, 0, it2 >> 1, it2 & 1, smem);
          else hyena_ctx_item(p, l, 0, (it2 - 512) >> 8, (it2 - 512) & 255, smem);
        }
      }
      const int nCA = last ? 0 : 256, u = blockIdx.x * 4 + w, nslots = gridDim.x * 4;
      for (int it = u; it < 4096; it += nslots) {
        if (it < 2048) na_item(p, l, it, (u16*)smem + w * 2 * AT_BUF);
        else sw_item(p, l, it - 2048, (u16*)smem + w * 2 * AT_BUF);
      }
      for (int c = nslots - 1 - u; c < nCA; c += nslots) ctxattn_item(p, l, c, (u16*)smem + w * 2 * AT_BUF);
    } break;
    case 3: {
      for (int i = blockIdx.x * 256 + tid; i < 8192; i += gridDim.x * 256) s5_passB_thread(p, i);
      const int nHy = 512 + (last ? 0 : 1024);
      for (int it = blockIdx.x; it < nHy; it += gridDim.x) {
        const int it2 = nHy - 1 - it;
        if (it2 < 512) hyena_mfma_item(p, l, 1, it2 >> 1, it2 & 1, smem);
        else hyena_ctx_item(p, l, 1, (it2 - 512) >> 8, (it2 - 512) & 255, smem);
      }
    } break;
    case 4: {
      for (int it = blockIdx.x; it < 640; it += gridDim.x) s5_out_tile(p, it / 40, (it % 40) / 5, it % 5, smem);
      const int ntt = last ? 64 : 68;
      for (int it = blockIdx.x; it < 16 * ntt; it += gridDim.x) {
        const int it2 = 16 * ntt - 1 - it;
        hyena_transpose_item(p, (it2 / ntt) >> 2, (it2 / ntt) & 3, it2 % ntt, smem);
      }
    } break;
    case 5: {
      const u16* G = (const u16*)(p.ws + OFF_S5G);
      u16* BR = (u16*)(p.ws + OFF_BR);
      for (int tile = blockIdx.x; tile < mtiles * 2; tile += gridDim.x) {
        const int m0 = (tile >> 1) * 128, n0 = (tile & 1) * 128;
        f32x16 acc[2][2]; zero_acc<2>(acc);
        gemm_acc<2>(G + (size_t)m0 * 256, 256, (const u16*)(p.ws + OFF_WGLU) + (size_t)n0 * 256, 256, 256, acc, (u16*)smem);
        FOR_ACC(acc, m0, n0, { float gg = bf2f(G[(size_t)row * 256 + col]); BR[(size_t)row * D + col] = f2bf(gg * sigmoidf_(v)); })
      }
    } break;
    case 6:
      n1024_items(last, [&](int m0, int n0) { merge_tile<2>(p, m0, n0, smem); }, [&](int m0, int n0) { merge_tile<1>(p, m0, n0, smem); });
      break;
    case 7:
      n1024_items(last, [&](int m0, int n0) { wout_tile<2>(p, l, m0, n0, smem); }, [&](int m0, int n0) { wout_tile<1>(p, l, m0, n0, smem); });
      break;
    case 8: {
      const int nrows = mtiles * 128, rs = gridDim.x * 4;
      float v[16], vn[16];
      int r = blockIdx.x * 4 + w;
      if (r < nrows) ln_load(xrow(p, r), vn);
      for (; r < nrows; r += rs) {
#pragma unroll
        for (int i = 0; i < 16; ++i) v[i] = vn[i];
        if (r + rs < nrows) ln_load(xrow(p, r + rs), vn);
        float* xr = xrow(p, r);
        ln_norm(v);
        ln_affine(v, p.in[29] + l * D, p.in[30] + l * D);
        ln_store_f32(v, xr);
        ln_norm(v);
        int bi = bidx_of_row(r);
        ln_store_mod(v, modp(p, l, bi, 3), modp(p, l, bi, 4), (u16*)(p.ws + OFF_H) + (size_t)r * D);
      }
    } break;
    case 9: {
      const u16* H = (const u16*)(p.ws + OFF_H);
      u16* HID = (u16*)(p.ws + OFF_HID);
      for (int tile = blockIdx.x; tile < mtiles * 32; tile += gridDim.x) {
        const int m0 = (tile >> 5) * 128, n0 = (tile & 31) * 128;
        f32x16 acc[2][2]; zero_acc<2>(acc);
        gemm_acc<2>(H + (size_t)m0 * D, D, (const u16*)(p.ws + OFF_W1) + (size_t)n0 * D, D, 1024, acc, (u16*)smem);
        {
          const int lane = tid & 63, r = lane & 31, h = lane >> 5;
          u16* slice = (u16*)smem + w * (64 * 72);
#pragma unroll
          for (int mi = 0; mi < 2; ++mi)
#pragma unroll
            for (int ni = 0; ni < 2; ++ni)
#pragma unroll
              for (int i = 0; i < 16; i += 2) {
                const float q0 = fmaxf(acc[mi][ni][i], 0.f), q1 = fmaxf(acc[mi][ni][i + 1], 0.f);
                const unsigned pk = pack2(q0 * q0, q1 * q1);
                slice[(mi * 32 + crow(i, h)) * 72 + ni * 32 + r] = (u16)(pk & 0xffffu);
                slice[(mi * 32 + crow(i + 1, h)) * 72 + ni * 32 + r] = (u16)(pk >> 16);
              }
          u16* hbase = HID + (size_t)(m0 + (w >> 1) * 64) * 4096 + n0 + (w & 1) * 64;
#pragma unroll
          for (int j = 0; j < 8; ++j) {
            const int row = (lane >> 3) + 8 * j, ch = (lane & 7) * 8;
            *(uint4*)(hbase + (size_t)row * 4096 + ch) = *(const uint4*)(slice + row * 72 + ch);
          }
          __syncthreads();
        }
      }
    } break;
    case 10:
      n1024_items(last, [&](int m0, int n0) { mlp2_tile<2>(p, l, m0, n0, smem); }, [&](int m0, int n0) { mlp2_tile<1>(p, l, m0, n0, smem); });
      break;
    case 11: {
      const int nrows = mtiles * 128, rs = gridDim.x * 4;
      float v[16], vn[16];
      int r = blockIdx.x * 4 + w;
      if (r < nrows) ln_load(xrow(p, r), vn);
      for (; r < nrows; r += rs) {
#pragma unroll
        for (int i = 0; i < 16; ++i) v[i] = vn[i];
        if (r + rs < nrows) ln_load(xrow(p, r + rs), vn);
        float* xr = xrow(p, r);
        ln_norm(v);
        ln_affine(v, p.in[33] + l * D, p.in[34] + l * D);
        ln_store_f32(v, xr);
        if (!last) {
          ln_norm(v);
          int bi = bidx_of_row(r);
          ln_store_mod(v, modp(p, l + 1, bi, 0), modp(p, l + 1, bi, 1), (u16*)(p.ws + OFF_H) + (size_t)r * D);
        }
      }
    } break;
  }
}


#define XB_TMO      128
#define XB_XCNT(j)  (256  + 64 * (j))
#define XB_XSUB(j)  (1280 + 64 * (j))
#define XB_XGEN(j)  (2304 + 64 * (j))
#define XB_TOP      3328
#define XB_TOPGEN   3392
#define XCD_BAR_WORDS 3456
#define XB_SPIN_CAP (1u << 22)
#define LAS __attribute__((address_space(3)))
DI unsigned xb_ld(unsigned* p) { return __hip_atomic_load(p, __ATOMIC_RELAXED, __HIP_MEMORY_SCOPE_AGENT); }
DI unsigned xb_add(unsigned* p, unsigned v) { return __hip_atomic_fetch_add(p, v, __ATOMIC_RELAXED, __HIP_MEMORY_SCOPE_AGENT); }
DI unsigned xb_xcc_id() { return (unsigned)__builtin_amdgcn_s_getreg((3 << 11) | 20) & 0xFu; }
#define XB_SPIN(cond, bar) do { unsigned _sp = 0; while (cond) { __builtin_amdgcn_s_sleep(1); \
    if ((++_sp & 255u) == 0u) { if (xb_ld(&(bar)[XB_TMO])) break; if (_sp > XB_SPIN_CAP) { atomicAdd(&(bar)[XB_TMO], 1u); break; } } } } while (0)
struct XcdBarrier { unsigned* bar; unsigned x; volatile LAS unsigned* st; };
DI XcdBarrier xcd_barrier_post(unsigned* bar, volatile LAS unsigned* st) {
  XcdBarrier b; b.bar = bar; b.x = xb_xcc_id(); b.st = st;
  if (threadIdx.x == 0) (void)xb_add(&bar[XB_XCNT(b.x)], 1u);
  return b;
}
DI void xcd_barrier_complete(unsigned* bar, unsigned x, unsigned& nloc, unsigned& nx) {
  const unsigned G = gridDim.x * gridDim.y * gridDim.z;
  unsigned sum, cnt, mine, sp = 0u;
  for (;;) {
    sum = 0u; cnt = 0u; mine = 0u;
#pragma unroll
    for (unsigned j = 0; j < 16; ++j) { const unsigned c = xb_ld(&bar[XB_XCNT(j)]); sum += c; cnt += (c > 0u) ? 1u : 0u; mine = (j == x) ? c : mine; }
    if (sum == G) break;
    __builtin_amdgcn_s_sleep(1);
    if ((++sp & 255u) == 0u) { if (xb_ld(&bar[XB_TMO])) break; if (sp > XB_SPIN_CAP) { atomicAdd(&bar[XB_TMO], 1u); break; } }
  }
  nloc = mine > 0u ? mine : 1u; nx = cnt > 0u ? cnt : 1u;
}
DI void xcd_barrier(const XcdBarrier& b) {
  asm volatile("s_waitcnt vmcnt(0)" ::: "memory");
  __syncthreads();
  if (threadIdx.x == 0) {
    unsigned* bar = b.bar;
    __builtin_amdgcn_s_waitcnt(0);
    unsigned nloc = b.st[0], nx = b.st[1];
    if (nloc == 0u) { xcd_barrier_complete(bar, b.x, nloc, nx); b.st[0] = nloc; b.st[1] = nx; }
    const unsigned old = xb_add(&bar[XB_XSUB(b.x)], 1u);
    const unsigned gen = old / nloc;
    if (old + 1u == (gen + 1u) * nloc) {
      __builtin_amdgcn_fence(__ATOMIC_RELEASE, "agent");
      asm volatile("s_waitcnt vmcnt(0)" ::: "memory");
      const unsigned og = xb_add(&bar[XB_TOP], 1u);
      const unsigned tg = og / nx;
      if (og + 1u == (tg + 1u) * nx) xb_add(&bar[XB_TOPGEN], 1u);
      else XB_SPIN(xb_ld(&bar[XB_TOPGEN]) == tg, bar);
      __builtin_amdgcn_fence(__ATOMIC_ACQUIRE, "agent");
      xb_add(&bar[XB_XGEN(b.x)], 1u);
      asm volatile("s_waitcnt vmcnt(0)" ::: "memory");
    } else {
      XB_SPIN(xb_ld(&bar[XB_XGEN(b.x)]) == gen, bar);
      __builtin_amdgcn_fence(__ATOMIC_ACQUIRE, "agent");
      asm volatile("s_waitcnt vmcnt(0)" ::: "memory");
    }
  }
  __syncthreads();
}

constexpr int NPHASE = 25;

__global__ void __launch_bounds__(256, 2) fwd_kernel(Params p) {
  extern __shared__ __attribute__((aligned(16))) char smem[];
  __shared__ uint4 xb_words;
  cg::grid_group grid = cg::this_grid();
  if (p.ph_lo > 1000) grid.sync();
  if (threadIdx.x == 0) xb_words = make_uint4(0u, 0u, 0u, 0u);
  __syncthreads();
  XcdBarrier xb = xcd_barrier_post((unsigned*)(p.ws + OFF_BAR), (volatile LAS unsigned*)&xb_words);
  for (int ph = p.ph_lo; ph < p.ph_hi; ++ph) {
    run_phase(p, ph, smem);
    if (ph + 1 < p.ph_hi) xcd_barrier(xb);
  }
}

extern "C" void kernel_launch(void* const* d_in, const int* in_sizes, int n_in, void* d_out, int out_size, void* d_ws, size_t ws_size,
                              hipStream_t stream) {
  static int grid_blocks = 0;
  if (!grid_blocks) {
    int dev = 0, cus = 0, per_cu = 0;
    hipGetDevice(&dev);
    hipDeviceGetAttribute(&cus, hipDeviceAttributeMultiprocessorCount, dev);
    hipFuncSetAttribute((const void*)fwd_kernel, hipFuncAttributeMaxDynamicSharedMemorySize, SMEM_BYTES);
    hipOccupancyMaxActiveBlocksPerMultiprocessor(&per_cu, (const void*)fwd_kernel, 256, SMEM_BYTES);
    if (per_cu < 1) per_cu = 1;
    if (per_cu > 2) per_cu = 2;
    grid_blocks = cus * per_cu;
    if (ws_size < OFF_END) fprintf(stderr, "kernel_launch: workspace too small: %zu < %zu\n", ws_size, (size_t)OFF_END);
  }
  Params p{};
  for (int i = 0; i < 35; ++i) p.in[i] = (const float*)d_in[i];
  p.out = (float*)d_out;
  p.ws = (char*)d_ws;
#if SINGLE_LAUNCH
  hipMemsetAsync((char*)d_ws + OFF_BAR, 0, XCD_BAR_WORDS * sizeof(unsigned), stream);
  p.ph_lo = 0; p.ph_hi = NPHASE;
  void* args[] = {&p};
  hipError_t e = hipLaunchCooperativeKernel((const void*)fwd_kernel, dim3(grid_blocks), dim3(256), args, SMEM_BYTES, stream);
  if (e != hipSuccess) fprintf(stderr, "cooperative launch failed: %s (grid %d)\n", hipGetErrorString(e), grid_blocks);
#else
  for (int ph = 0; ph < NPHASE; ++ph) {
    p.ph_lo = ph; p.ph_hi = ph + 1;
    hipLaunchKernelGGL(fwd_kernel, dim3(grid_blocks), dim3(256), SMEM_BYTES, stream, p);
  }
#endif
}
```

```cpp
#include <hip/hip_runtime.h>
#include <hip/hip_cooperative_groups.h>
#include <stdint.h>
#include <stdio.h>
namespace cg = cooperative_groups;

#ifndef SINGLE_LAUNCH
#define SINGLE_LAUNCH 1
#endif

#define DI __device__ __forceinline__
typedef unsigned short u16;
typedef __attribute__((ext_vector_type(8))) short bf16x8;
typedef __attribute__((ext_vector_type(4))) short bf16x4;
typedef __attribute__((ext_vector_type(16))) float f32x16;
typedef __attribute__((ext_vector_type(4))) unsigned u32x4;

constexpr int D = 1024, NBATCH = 4, SEQ = 4096, CTX = 256;
constexpr int NLAT = NBATCH * SEQ, NCTX = NBATCH * CTX, NROW = NLAT + NCTX;
constexpr int ZW = 1152, INTOT = 6400, TOKS = SEQ + CTX;
constexpr int NCHUNK = 68;
constexpr float LN_EPS = 1e-6f;
constexpr float ALPHA = 1.41421356237f;

constexpr size_t OFF_MOD = 0;
constexpr size_t OFF_ROPE = 262144;
constexpr size_t OFF_S5A = OFF_ROPE + 8192;
constexpr size_t OFF_S5BB = OFF_S5A + 16384;
constexpr size_t SZ_S5ST = (size_t)2 * 4 * NCHUNK * 16 * 64 * 2 * 4;
constexpr size_t OFF_S5S = OFF_S5BB + 262144;
constexpr size_t OFF_S5H = OFF_S5S + SZ_S5ST;
constexpr size_t OFF_XC = OFF_S5H + SZ_S5ST;
constexpr size_t OFF_WIN = OFF_XC + (size_t)NCTX * D * 4;
constexpr size_t OFF_WBR = OFF_WIN + (size_t)INTOT * D * 2;
constexpr size_t OFF_WO = OFF_WBR + (size_t)4 * 1024 * 256 * 2;
constexpr size_t OFF_W1 = OFF_WO + (size_t)1024 * 1024 * 2;
constexpr size_t OFF_W2 = OFF_W1 + (size_t)4096 * 1024 * 2;
constexpr size_t OFF_WGLU = OFF_W2 + (size_t)4096 * 1024 * 2;
constexpr size_t OFF_FILTR = OFF_WGLU + (size_t)256 * 256 * 2;
constexpr size_t OFF_FCTX = OFF_FILTR + (size_t)2 * 256 * 8192 * 2;
constexpr size_t OFF_H = OFF_FCTX + (size_t)2 * 256 * 512 * 4;
constexpr size_t OFF_BIG = OFF_H + (size_t)NROW * D * 2;
constexpr size_t OFF_ZMIX = OFF_BIG;
constexpr size_t OFF_HYV1 = OFF_ZMIX + (size_t)NROW * ZW * 2;
constexpr size_t OFF_S5G = OFF_HYV1 + (size_t)NROW * 256 * 2;
constexpr size_t OFF_BR = OFF_S5G + (size_t)NROW * 256 * 2;
constexpr size_t OFF_VTNA = OFF_BR + (size_t)NROW * D * 2;
constexpr size_t OFF_VTSW = OFF_VTNA + (size_t)4 * 256 * TOKS * 2;
constexpr size_t OFF_HYT = OFF_VTSW + (size_t)4 * 128 * TOKS * 2;
constexpr size_t OFF_HYO = OFF_HYT + (size_t)4 * 768 * TOKS * 2;
constexpr size_t OFF_END = OFF_HYO + (size_t)4 * 256 * TOKS * 2;
constexpr size_t OFF_MERGED = OFF_BIG;
constexpr size_t OFF_HID = OFF_BIG;
static_assert((size_t)NROW * 4096 * 2 <= OFF_END - OFF_BIG, "hid alias");
constexpr size_t OFF_BAR = OFF_END;
constexpr int NCOL = 4 * NCHUNK;
constexpr size_t OFF_K2 = OFF_BAR + 16384;
constexpr size_t OFF_PT = OFF_K2 + (size_t)16 * 127 * 256 * 2;
constexpr size_t OFF_ET = OFF_PT + (size_t)16 * 256 * 1024 * 2;
constexpr size_t OFF_HB = OFF_ET + (size_t)16 * 1024 * 256 * 2;
constexpr size_t OFF_END2 = OFF_HB + (size_t)16 * NCOL * 256 * 2;
constexpr size_t OFF_S5D = OFF_END2;
static_assert(OFF_S5D + 65536 <= (size_t)256 * 1024 * 1024, "ws");

constexpr int LDT = 72;
constexpr int TILE_ELEMS = 128 * LDT;
constexpr int SMEM_BYTES = 4 * TILE_ELEMS * 2;

struct Params {
  const float* in[35];
  float* out;
  char* ws;
  int ph_lo, ph_hi;
};

DI int tidx() { int t = threadIdx.x; asm volatile("" : "+v"(t)); return t; }
typedef float f32x2 __attribute__((ext_vector_type(2)));
typedef __bf16 bf16x2_t __attribute__((ext_vector_type(2)));
DI unsigned pack2(float a, float b) { f32x2 v = {a, b}; bf16x2_t r = __builtin_convertvector(v, bf16x2_t); return __builtin_bit_cast(unsigned, r); }
DI u16 f2bf(float x) { return (u16)(pack2(x, 0.f) & 0xffffu); }
DI float bf2f(u16 v) { return __uint_as_float(((unsigned)v) << 16); }
DI int crow(int i, int h) { return (i & 3) + 8 * (i >> 2) + 4 * h; }
DI float wsum(float v) { for (int o = 32; o > 0; o >>= 1) v += __shfl_xor(v, o); return v; }
DI float sigmoidf_(float x) { return 1.f / (1.f + __expf(-x)); }
DI float gelu_tanh(float x) { float u = 0.7978845608028654f * (x + 0.044715f * x * x * x); return 0.5f * x * (1.f + tanhf(u)); }
#define MFMA32(a, b, c) __builtin_amdgcn_mfma_f32_32x32x16_bf16((a), (b), (c), 0, 0, 0)

DI int bidx_of_row(int r) { return r < NLAT ? (r >> 12) : 4; }
DI float* xrow(const Params& p, int r) { return r < NLAT ? p.out + (size_t)r * D : (float*)(p.ws + OFF_XC) + (size_t)(r - NLAT) * D; }
DI const float* xin_row(const Params& p, int l, int r) {
  if (l == 0) return r < NLAT ? p.in[0] + (size_t)r * D : p.in[2] + (size_t)(r - NLAT) * D;
  return xrow(p, r);
}
DI const float* modp(const Params& p, int l, int bi, int part) { return (const float*)(p.ws + OFF_MOD) + ((size_t)(l * 5 + bi) * 6144 + part * 1024); }

template <int NI, class FA, class FB>
DI void g_load(u32x4 (&ra)[4], u32x4 (&rb)[2 * NI], FA fa, FB fb, int kt) {
#pragma unroll
  for (int i = 0; i < 4; ++i) ra[i] = *(const u32x4*)fa(i, kt);
#pragma unroll
  for (int i = 0; i < 2 * NI; ++i) rb[i] = *(const u32x4*)fb(i, kt);
}
template <int NI>
DI void g_store(const u32x4 (&ra)[4], const u32x4 (&rb)[2 * NI], u16* sa, u16* sb) {
#pragma unroll
  for (int i = 0; i < 4; ++i) *(u32x4*)(sa + i * 32 * LDT) = ra[i];
#pragma unroll
  for (int i = 0; i < 2 * NI; ++i) *(u32x4*)(sb + i * 32 * LDT) = rb[i];
}
template <int NI, bool SWAP = false>
DI void g_compute(f32x16 (&acc)[2][NI], const u16* ab, const u16* bb) {
  __builtin_amdgcn_s_setprio(1);
#pragma unroll
  for (int ks = 0; ks < 4; ++ks) {
    bf16x8 a0 = *(const bf16x8*)(ab + ks * 16), a1 = *(const bf16x8*)(ab + 32 * LDT + ks * 16);
#pragma unroll
    for (int ni = 0; ni < NI; ++ni) {
      bf16x8 b0 = *(const bf16x8*)(bb + ni * 32 * LDT + ks * 16);
      if (SWAP) {
        acc[0][ni] = MFMA32(b0, a0, acc[0][ni]);
        acc[1][ni] = MFMA32(b0, a1, acc[1][ni]);
      } else {
        acc[0][ni] = MFMA32(a0, b0, acc[0][ni]);
        acc[1][ni] = MFMA32(a1, b0, acc[1][ni]);
      }
    }
  }
  __builtin_amdgcn_s_setprio(0);
}
template <int NI, bool SWAP = false, class FA, class FB>
DI void gemm_acc_f(FA fa, FB fb, int nk, f32x16 (&acc)[2][NI], u16* sm) {
  const int tid = tidx(), lane = tid & 63, w = tid >> 6, wm = w >> 1, wn = w & 1, r = lane & 31, h = lane >> 5;
  const int lrow = tid >> 3, lch = tid & 7;
  u16* sa0 = sm + lrow * LDT + lch * 8;
  u16* sa1 = sa0 + TILE_ELEMS;
  u16* sb0 = sm + 2 * TILE_ELEMS + lrow * LDT + lch * 8;
  u16* sb1 = sb0 + TILE_ELEMS;
  const u16* ab0 = sm + (wm * 64 + r) * LDT + h * 8;
  const u16* ab1 = ab0 + TILE_ELEMS;
  const u16* bb0 = sm + 2 * TILE_ELEMS + (wn * 32 * NI + r) * LDT + h * 8;
  const u16* bb1 = bb0 + TILE_ELEMS;
  u32x4 ra0[4], ra1[4], rb0[2 * NI], rb1[2 * NI];
  g_load<NI>(ra0, rb0, fa, fb, 0);
  g_load<NI>(ra1, rb1, fa, fb, 1);
  g_store<NI>(ra0, rb0, sa0, sb0);
  __syncthreads();
  for (int kt = 0; kt < nk; kt += 2) {
    if (kt + 2 < nk) g_load<NI>(ra0, rb0, fa, fb, kt + 2);
    g_compute<NI, SWAP>(acc, ab0, bb0);
    g_store<NI>(ra1, rb1, sa1, sb1);
    __syncthreads();
    if (kt + 3 < nk) g_load<NI>(ra1, rb1, fa, fb, kt + 3);
    g_compute<NI, SWAP>(acc, ab1, bb1);
    if (kt + 2 < nk) g_store<NI>(ra0, rb0, sa0, sb0);
    __syncthreads();
  }
}
template <int NI, class FA, class FB>
DI void gemm_acc_f1(FA fa, FB fb, int nk, f32x16 (&acc)[2][NI], u16* sm) {
  const int tid = tidx(), lane = tid & 63, w = tid >> 6, wm = w >> 1, wn = w & 1, r = lane & 31, h = lane >> 5;
  const int lrow = tid >> 3, lch = tid & 7;
  u16* sa0 = sm + lrow * LDT + lch * 8;
  u16* sb0 = sm + 2 * TILE_ELEMS + lrow * LDT + lch * 8;
  const u16* ab0 = sm + (wm * 64 + r) * LDT + h * 8;
  const u16* bb0 = sm + 2 * TILE_ELEMS + (wn * 32 * NI + r) * LDT + h * 8;
  u32x4 ra0[4], rb0[2 * NI];
  g_load<NI>(ra0, rb0, fa, fb, 0);
  g_store<NI>(ra0, rb0, sa0, sb0);
  __syncthreads();
  for (int kt = 0; kt < nk; ++kt) {
    const int cur = kt & 1;
    if (kt + 1 < nk) g_load<NI>(ra0, rb0, fa, fb, kt + 1);
    g_compute<NI>(acc, ab0 + cur * TILE_ELEMS, bb0 + cur * TILE_ELEMS);
    if (kt + 1 < nk) g_store<NI>(ra0, rb0, sa0 + (cur ^ 1) * TILE_ELEMS, sb0 + (cur ^ 1) * TILE_ELEMS);
    __syncthreads();
  }
}
template <int NI, bool SWAP = false>
DI void gemm_acc(const u16* __restrict__ A, int lda, const u16* __restrict__ B, int ldb, int K, f32x16 (&acc)[2][NI], u16* sm) {
  const int tid = tidx(), lrow = tid >> 3, lch = tid & 7;
  const u16* ga = A + (size_t)lrow * lda + lch * 8;
  const u16* gb = B + (size_t)lrow * ldb + lch * 8;
  gemm_acc_f<NI, SWAP>([=](int i, int kt) { return ga + (size_t)i * 32 * lda + kt * 64; },
                       [=](int i, int kt) { return gb + (size_t)i * 32 * ldb + kt * 64; }, K >> 6, acc, sm);
}
template <int NI>
DI void zero_acc(f32x16 (&acc)[2][NI]) {
#pragma unroll
  for (int a = 0; a < 2; ++a)
#pragma unroll
    for (int b = 0; b < NI; ++b)
#pragma unroll
      for (int i = 0; i < 16; ++i) acc[a][b][i] = 0.f;
}
#define FOR_ACC(acc, m0, n0, BODY)                                                                  \
  {                                                                                                 \
    const int lane_ = tidx() & 63, w_ = tidx() >> 6, r_ = lane_ & 31, h_ = lane_ >> 5;     \
    _Pragma("unroll") for (int mi_ = 0; mi_ < 2; ++mi_) _Pragma("unroll") for (int ni_ = 0; ni_ < 2; ++ni_) \
    _Pragma("unroll") for (int i_ = 0; i_ < 16; ++i_) {                                             \
      const int row = (m0) + (w_ >> 1) * 64 + mi_ * 32 + crow(i_, h_);                              \
      const int col = (n0) + (w_ & 1) * 64 + ni_ * 32 + r_;                                         \
      const float v = acc[mi_][ni_][i_];                                                               \
      BODY                                                                                          \
    }                                                                                               \
  }

DI void s5_disc_compute(const Params& p, int l, int si, float& lm, float& th, float& f_re, float& f_im);
DI void phase_mod(const Params& p, char* smem) {
  const int tid = tidx();
  float* sc = (float*)smem;
  float* red = sc + 5 * 1024;
  for (int i = tid; i < 5 * 1024; i += 256) {
    int j = i >> 10, k = i & 1023;
    float v = j < 4 ? p.in[1][j * 1024 + k] : p.in[3][k];
    sc[i] = v / (1.f + __expf(-v));
  }
  __syncthreads();
  for (int item = blockIdx.x; item < 2 * 96; item += gridDim.x) {
    const int l = item / 96, ct = item % 96, cl = tid & 63, kg = tid >> 6, col = ct * 64 + cl;
    const float* W = p.in[4] + (size_t)l * 1024 * 6144 + col;
    float a0 = 0, a1 = 0, a2 = 0, a3 = 0, a4 = 0;
#pragma unroll 8
    for (int k = kg * 256; k < kg * 256 + 256; ++k) {
      float wv = W[(size_t)k * 6144];
      a0 += sc[k] * wv; a1 += sc[1024 + k] * wv; a2 += sc[2048 + k] * wv; a3 += sc[3072 + k] * wv; a4 += sc[4096 + k] * wv;
    }
    float* rr = red + (kg * 64 + cl) * 5;
    rr[0] = a0; rr[1] = a1; rr[2] = a2; rr[3] = a3; rr[4] = a4;
    __syncthreads();
    if (tid < 64) {
      float bv = p.in[5][l * 6144 + col];
      float* mo = (float*)(p.ws + OFF_MOD);
      for (int j = 0; j < 5; ++j) {
        float s = red[(0 * 64 + cl) * 5 + j] + red[(1 * 64 + cl) * 5 + j] + red[(2 * 64 + cl) * 5 + j] + red[(3 * 64 + cl) * 5 + j];
        mo[(size_t)(l * 5 + j) * 6144 + col] = s + bv;
      }
    }
    __syncthreads();
  }
  for (int i = blockIdx.x * 256 + tid; i < 4096; i += gridDim.x * 256) {
    float lm, th, fr, fi; s5_disc_compute(p, i >> 11, i & 2047, lm, th, fr, fi);
    *(float4*)((float*)(p.ws + OFF_S5D) + (size_t)i * 4) = make_float4(lm, th, fr, fi);
  }
  for (int i = blockIdx.x * 256 + tid; i < 1024; i += gridDim.x * 256) {
    int pos = i >> 4, m = i & 15;
    float inv = powf(10000.f, -(float)m / 16.f);
    float s, c; sincosf((float)pos * inv, &s, &c);
    float* rt = (float*)(p.ws + OFF_ROPE);
    rt[i * 2] = c; rt[i * 2 + 1] = s;
  }
}

DI void convT_tile(const float* __restrict__ src, int K, int N, u16* __restrict__ dst, int kt, int nt, float* tile) {
  const int tid = tidx();
#pragma unroll
  for (int q = 0; q < 4; ++q) {
    const int e = tid + q * 256, i = e >> 4, j4 = (e & 15) * 4;
    const float4 v = *(const float4*)(src + (size_t)(kt * 64 + i) * N + nt * 64 + j4);
    tile[i * 65 + j4] = v.x; tile[i * 65 + j4 + 1] = v.y; tile[i * 65 + j4 + 2] = v.z; tile[i * 65 + j4 + 3] = v.w;
  }
  __syncthreads();
#pragma unroll
  for (int q = 0; q < 2; ++q) {
    const int e = tid + q * 256, j = e >> 3, i8 = (e & 7) * 8;
    uint4 o;
    o.x = pack2(tile[(i8 + 0) * 65 + j], tile[(i8 + 1) * 65 + j]); o.y = pack2(tile[(i8 + 2) * 65 + j], tile[(i8 + 3) * 65 + j]);
    o.z = pack2(tile[(i8 + 4) * 65 + j], tile[(i8 + 5) * 65 + j]); o.w = pack2(tile[(i8 + 6) * 65 + j], tile[(i8 + 7) * 65 + j]);
    *(uint4*)(dst + (size_t)(nt * 64 + j) * K + kt * 64 + i8) = o;
  }
  __syncthreads();
}

DI void ln_load(const float* __restrict__ src, float (&v)[16]) {
  const int lane = tidx() & 63;
#pragma unroll
  for (int i = 0; i < 4; ++i) { float4 t = *(const float4*)(src + i * 256 + lane * 4); v[i * 4] = t.x; v[i * 4 + 1] = t.y; v[i * 4 + 2] = t.z; v[i * 4 + 3] = t.w; }
}
DI void ln_norm(float (&v)[16]) {
  float s = 0;
#pragma unroll
  for (int i = 0; i < 16; ++i) s += v[i];
  float mu = wsum(s) * (1.f / 1024.f);
  float q = 0;
#pragma unroll
  for (int i = 0; i < 16; ++i) { v[i] -= mu; q += v[i] * v[i]; }
  float rstd = rsqrtf(wsum(q) * (1.f / 1024.f) + LN_EPS);
#pragma unroll
  for (int i = 0; i < 16; ++i) v[i] *= rstd;
}
DI void ln_store_mod(const float (&v)[16], const float* __restrict__ sh, const float* __restrict__ scl, u16* __restrict__ dst) {
  const int lane = tidx() & 63;
#pragma unroll
  for (int i = 0; i < 4; ++i) {
    int c = i * 256 + lane * 4;
    float4 s4 = *(const float4*)(sh + c), c4 = *(const float4*)(scl + c);
    uint2 o;
    o.x = pack2(v[i * 4] * (1.f + c4.x) + s4.x, v[i * 4 + 1] * (1.f + c4.y) + s4.y);
    o.y = pack2(v[i * 4 + 2] * (1.f + c4.z) + s4.z, v[i * 4 + 3] * (1.f + c4.w) + s4.w);
    *(uint2*)(dst + c) = o;
  }
}
DI void ln_affine(float (&v)[16], const float* __restrict__ g, const float* __restrict__ b) {
  const int lane = tidx() & 63;
#pragma unroll
  for (int i = 0; i < 4; ++i) {
    int c = i * 256 + lane * 4;
    float4 g4 = *(const float4*)(g + c), b4 = *(const float4*)(b + c);
    v[i * 4] = v[i * 4] * g4.x + b4.x; v[i * 4 + 1] = v[i * 4 + 1] * g4.y + b4.y; v[i * 4 + 2] = v[i * 4 + 2] * g4.z + b4.z; v[i * 4 + 3] = v[i * 4 + 3] * g4.w + b4.w;
  }
}
DI void ln_store_f32(const float (&v)[16], float* __restrict__ dst) {
  const int lane = tidx() & 63;
#pragma unroll
  for (int i = 0; i < 4; ++i) *(float4*)(dst + i * 256 + lane * 4) = make_float4(v[i * 4], v[i * 4 + 1], v[i * 4 + 2], v[i * 4 + 3]);
}

DI void hyena_filter_item(const Params& p, int l, int n, int pos0, float* sm) {
  const int tid = tidx();
  float* feats = sm;
  float* h1 = sm + 9 * 36;
  float* h2 = h1 + 9 * 64;
  for (int e = tid; e < 9 * 33; e += 256) {
    int pi = e / 33, k = e % 33, pos = pos0 + pi;
    float f;
    if (k == 0) f = (float)pos / (float)(n - 1);
    else {
      int bi = (k - 1) & 15;
      float band = 1e-4f + (15.f - 1e-4f) * (float)bi / 15.f;
      float ang = 6.283185307179586f * band * (float)pos / (float)n;
      float sn, cs; sincosf(ang, &sn, &cs);
      f = k <= 16 ? cs : -sn;
    }
    feats[pi * 36 + k] = f;
  }
  __syncthreads();
  for (int e = tid; e < 9 * 64; e += 256) {
    int pi = e >> 6, j = e & 63;
    const float* w1 = p.in[19] + (size_t)l * 33 * 64;
    float a = p.in[20][l * 64 + j];
    for (int k = 0; k < 33; ++k) a += feats[pi * 36 + k] * w1[k * 64 + j];
    h1[e] = sinf(p.in[18][(l * 2 + 0) * 64 + j] * a);
  }
  __syncthreads();
  for (int e = tid; e < 9 * 64; e += 256) {
    int pi = e >> 6, j = e & 63;
    const float* w2 = p.in[21] + (size_t)l * 64 * 64;
    float a = p.in[22][l * 64 + j];
    for (int k = 0; k < 64; ++k) a += h1[pi * 64 + k] * w2[k * 64 + j];
    h2[e] = sinf(p.in[18][(l * 2 + 1) * 64 + j] * a);
  }
  __syncthreads();
  const float* w3 = p.in[23] + (size_t)l * 64 * 1024;
  for (int q = 0; q < 4; ++q) {
    const int idx = q * 256 + tid, dirn = idx >> 9, o = (idx >> 8) & 1, c = idx & 255;
    float wc[64];
#pragma unroll
    for (int k = 0; k < 64; ++k) wc[k] = w3[k * 1024 + idx];
    const float delta = fabsf(-3.0701134573253944f + (-15.350567286626972f + 3.0701134573253944f) * (float)c / 255.f);
    float out[8];
#pragma unroll
    for (int e = 0; e < 8; ++e) {
      const int pi = e + dirn, pos = pos0 + pi;
      float a = 0.f;
#pragma unroll
      for (int k = 0; k < 64; k += 4) {
        float4 hh = *(const float4*)(h2 + pi * 64 + k);
        a += hh.x * wc[k] + hh.y * wc[k + 1] + hh.z * wc[k + 2] + hh.w * wc[k + 3];
      }
      a *= __expf(-((float)pos / (float)(n - 1)) * delta);
      if (dirn == 0 && pos == 0) a += p.in[24][(l * 2 + o) * 256 + c];
      if (pos >= n) a = 0.f;
      out[e] = a;
    }
    if (n == 4096) {
      u16* FR = (u16*)(p.ws + OFF_FILTR) + ((size_t)o * 256 + c) * 8192;
      uint4 v;
      if (dirn == 0) {
        v.x = pack2(out[7], out[6]); v.y = pack2(out[5], out[4]); v.z = pack2(out[3], out[2]); v.w = pack2(out[1], out[0]);
        *(uint4*)(FR + 4088 - pos0) = v;
      } else {
        v.x = pack2(out[0], out[1]); v.y = pack2(out[2], out[3]); v.z = pack2(out[4], out[5]); v.w = pack2(out[6], out[7]);
        *(uint4*)(FR + 4096 + pos0) = v;
      }
    } else {
      float* FC = (float*)(p.ws + OFF_FCTX) + ((size_t)o * 256 + c) * 512 + 256;
#pragma unroll
      for (int e = 0; e < 8; ++e) {
        const int pos = pos0 + e + dirn;
        if (pos < n) { if (dirn == 0) FC[pos] = out[e]; else FC[-pos] = out[e]; }
      }
    }
  }
  __syncthreads();
}

DI void s5_k2_thread(const Params& p, int l, int idx);
DI void s5_pe_thread(const Params& p, int l, int idx);
DI void phase_prep(const Params& p, int l, char* smem, bool do_abc, bool do_d, bool do_tab) {
  const int tid = tidx();
  float* smf = (float*)smem;
  if (do_abc) {
  for (int item = blockIdx.x; item < 4176; item += gridDim.x) {
    int it = item;
    if (it < 1600) { convT_tile(p.in[6] + (size_t)l * 1024 * INTOT, 1024, INTOT, (u16*)(p.ws + OFF_WIN), it / 100, it % 100, smf); continue; }
    it -= 1600;
    if (it < 256) { int n = it >> 6, t = it & 63; convT_tile(p.in[27] + ((size_t)l * 4 + n) * 256 * 1024, 256, 1024, (u16*)(p.ws + OFF_WBR) + (size_t)n * 1024 * 256, t >> 4, t & 15, smf); continue; }
    it -= 256;
    if (it < 256) { convT_tile(p.in[28] + (size_t)l * 1024 * 1024, 1024, 1024, (u16*)(p.ws + OFF_WO), it >> 4, it & 15, smf); continue; }
    it -= 256;
    if (it < 1024) { convT_tile(p.in[31] + (size_t)l * 1024 * 4096, 1024, 4096, (u16*)(p.ws + OFF_W1), it >> 6, it & 63, smf); continue; }
    it -= 1024;
    if (it < 1024) { convT_tile(p.in[32] + (size_t)l * 4096 * 1024, 4096, 1024, (u16*)(p.ws + OFF_W2), it >> 4, it & 15, smf); continue; }
    it -= 1024;
    convT_tile(p.in[15] + (size_t)l * 256 * 256, 256, 256, (u16*)(p.ws + OFF_WGLU), it >> 2, it & 3, smf);
  }
  for (int item = blockIdx.x; item < 512 + 32; item += gridDim.x) {
    if (item < 512) hyena_filter_item(p, l, 4096, item * 8, smf);
    else hyena_filter_item(p, l, 256, (item - 512) * 8, smf);
  }
  for (int i = blockIdx.x * 256 + tid; i < 2048; i += gridDim.x * 256) {
    int dir = i >> 10, g = (i >> 6) & 15;
    float lre = p.in[7][l * 2048 + i], lim = p.in[8][l * 2048 + i];
    float dt = __expf(p.in[9][(l * 2 + dir) * 16 + g]);
    float th = lim * dt, sn, cs; sincosf(th, &sn, &cs);
    float em1 = expm1f(lre * dt), mag = em1 + 1.f;
    float a_re = mag * cs, a_im = mag * sn;
    float sh = sinf(0.5f * th);
    float are_m1 = em1 * cs - 2.f * sh * sh;
    float den = lre * lre + lim * lim;
    float f_re = (are_m1 * lre + a_im * lim) / den, f_im = (a_im * lre - are_m1 * lim) / den;
    float* A = (float*)(p.ws + OFF_S5A);
    A[i * 2] = a_re; A[i * 2 + 1] = a_im;
    float* BB = (float*)(p.ws + OFF_S5BB) + (size_t)i * 32;
    const float* bre = p.in[10] + ((size_t)l * 2048 + i) * 16;
    const float* bim = p.in[11] + ((size_t)l * 2048 + i) * 16;
    for (int n = 0; n < 16; ++n) { float br = bre[n], bi = bim[n]; BB[n * 2] = f_re * br - f_im * bi; BB[n * 2 + 1] = f_re * bi + f_im * br; }
  }
  }
  if (do_tab) {
    for (int i = blockIdx.x * 256 + tid; i < 65536; i += gridDim.x * 256) s5_k2_thread(p, l, i);
    for (int i = blockIdx.x * 256 + tid; i < 131072; i += gridDim.x * 256) s5_pe_thread(p, l, i);
  }
  if (l == 0 && do_d) {
    const int w = tid >> 6;
    const int rs = gridDim.x * 4;
    float v[16], vn[16];
    int r = blockIdx.x * 4 + w;
    if (r < NROW) ln_load(xin_row(p, 0, r), vn);
    for (; r < NROW; r += rs) {
#pragma unroll
      for (int i = 0; i < 16; ++i) v[i] = vn[i];
      if (r + rs < NROW) ln_load(xin_row(p, 0, r + rs), vn);
      ln_norm(v);
      int bi = bidx_of_row(r);
      ln_store_mod(v, modp(p, 0, bi, 0), modp(p, 0, bi, 1), (u16*)(p.ws + OFF_H) + (size_t)r * D);
    }
  }
}

DI void phase_inproj(const Params& p, int l, char* smem) {
  const u16* H = (const u16*)(p.ws + OFF_H);
  const u16* W = (const u16*)(p.ws + OFF_WIN);
  u16* Z = (u16*)(p.ws + OFF_ZMIX);
  const float* rope = (const float*)(p.ws + OFF_ROPE);
  const int lane = tidx() & 63, w = tidx() >> 6, r = lane & 31, h = lane >> 5;
  const bool xcd_order = (gridDim.x & 7) == 0;
  const int nloc = xcd_order ? 17 * 18 : 136 * 18, q0 = xcd_order ? (int)(blockIdx.x >> 3) : (int)blockIdx.x, qs = xcd_order ? (int)(gridDim.x >> 3) : (int)gridDim.x;
  for (int q = q0; q < nloc; q += qs) {
    const int mt = xcd_order ? (int)(blockIdx.x & 7) + 8 * (q / 18) : q / 18, nt = q % 18, m0 = mt * 128, n0 = nt * 128;
    f32x16 acc[2][2];
    zero_acc<2>(acc);
    const int cbase = n0 + (w & 1) * 64, rbase = m0 + (w >> 1) * 64;
    const bool thy = cbase >= 256 && cbase < 1024, vna = cbase >= 1536 && cbase < 1792, vsw = cbase >= 2176;
    const bool tr = (n0 >= 256 && n0 < 1024) || (n0 >= 1536 && n0 < 1792) || n0 >= 2176;
    if (tr) {
      gemm_acc<2, true>(H + (size_t)m0 * D, D, W + (size_t)n0 * D, D, 1024, acc, (u16*)smem);
      u16* VT = (u16*)(p.ws + (thy ? OFF_HYT : (vna ? OFF_VTNA : OFF_VTSW)));
      const int CV = thy ? 768 : (vna ? 256 : 128), c0 = thy ? 256 : (vna ? 1536 : 2176);
#pragma unroll
      for (int mi = 0; mi < 2; ++mi) {
        const int row = rbase + mi * 32 + r;
        int b, tok;
        if (row < NLAT) { b = row >> 12; tok = row & 4095; } else { int rr = row - NLAT; b = rr >> 8; tok = 4096 + (rr & 255); }
        u16* vrow = VT + (size_t)(b * CV + cbase - c0) * TOKS + tok;
#pragma unroll
        for (int ni = 0; ni < 2; ++ni)
#pragma unroll
          for (int i = 0; i < 16; ++i) vrow[(size_t)(ni * 32 + crow(i, h)) * TOKS] = f2bf(acc[mi][ni][i]);
      }
    } else {
      gemm_acc<2>(H + (size_t)m0 * D, D, W + (size_t)n0 * D, D, 1024, acc, (u16*)smem);
      if (cbase >= 1792 && m0 < NLAT) {
#pragma unroll
        for (int mi = 0; mi < 2; ++mi)
#pragma unroll
          for (int i = 0; i < 16; ++i) {
            int t = (rbase + mi * 32 + crow(i, h)) & 4095;
            int pos = r < 16 ? (t >> 6) : (t & 63);
            float cs = rope[(pos * 16 + (r & 15)) * 2], sn = rope[(pos * 16 + (r & 15)) * 2 + 1];
            float x1 = acc[mi][0][i], x2 = acc[mi][1][i];
            acc[mi][0][i] = x1 * cs - x2 * sn;
            acc[mi][1][i] = x1 * sn + x2 * cs;
          }
      }
      const int zoff = cbase < 256 ? 0 : (cbase < 1536 ? 768 : 1024);
      FOR_ACC(acc, m0, n0, { Z[(size_t)row * ZW + col - zoff] = f2bf(v); })
    }
  }
}

struct AttnSt { f32x16 o0, o1; float m, l; };
DI void attn_init(AttnSt& S) {
#pragma unroll
  for (int i = 0; i < 16; ++i) { S.o0[i] = 0.f; S.o1[i] = 0.f; }
  S.m = -1e30f; S.l = 0.f;
}
template <class SF>
DI void attn_compute(AttnSt& S, const bf16x8 (&qf)[4], const bf16x8 (&kf)[4], const bf16x8 (&vf)[4], SF sf) {
  f32x16 st;
#pragma unroll
  for (int i = 0; i < 16; ++i) st[i] = 0.f;
#pragma unroll
  for (int ks = 0; ks < 4; ++ks) st = MFMA32(kf[ks], qf[ks], st);
  float mx = -1e30f;
#pragma unroll
  for (int i = 0; i < 16; ++i) { float s = sf(i, st[i] * 0.125f); st[i] = s; mx = fmaxf(mx, s); }
  mx = fmaxf(mx, __shfl_xor(mx, 32));
  const float mn = fmaxf(S.m, mx), alpha = __expf(S.m - mn);
  S.m = mn;
  float ps = 0.f;
#pragma unroll
  for (int i = 0; i < 16; ++i) { float e = __expf(st[i] - mn); st[i] = e; ps += e; }
  S.l = S.l * alpha + ps;
#pragma unroll
  for (int i = 0; i < 16; ++i) { S.o0[i] *= alpha; S.o1[i] *= alpha; }
#pragma unroll
  for (int s = 0; s < 2; ++s) {
    union { unsigned u[4]; bf16x8 v; } pf;
#pragma unroll
    for (int j = 0; j < 4; ++j) pf.u[j] = pack2(st[8 * s + 2 * j], st[8 * s + 2 * j + 1]);
    S.o0 = MFMA32(vf[2 * s], pf.v, S.o0);
    S.o1 = MFMA32(vf[2 * s + 1], pf.v, S.o1);
  }
}
constexpr int AT_KLD = 72, AT_VLD = 36, AT_BUF = 32 * AT_KLD + 64 * AT_VLD;
template <class PF, class SF>
DI void attn_run(AttnSt& S, const bf16x8 (&qf)[4], int nblk, PF pf, SF sf, u16* lds  ) {
  const int lane = tidx() & 63, r = lane & 31, h = lane >> 5;
  const int kr = lane >> 3, kc = (lane & 7) * 8, vr = lane >> 2, vc = (lane & 3) * 8;
  u32x4 gk[4], gv[4];
  {
    const u16 *kb, *vb;
    pf(0, kb, vb);
#pragma unroll
    for (int j = 0; j < 4; ++j) { gk[j] = *(const u32x4*)(kb + (size_t)(kr + 8 * j) * ZW + kc); gv[j] = *(const u32x4*)(vb + (size_t)(vr + 16 * j) * TOKS + vc); }
#pragma unroll
    for (int j = 0; j < 4; ++j) { *(u32x4*)(lds + (kr + 8 * j) * AT_KLD + kc) = gk[j]; *(uint2*)(lds + 32 * AT_KLD + (vr + 16 * j) * AT_VLD + vc) = make_uint2(gv[j][0], gv[j][1]); *(uint2*)(lds + 32 * AT_KLD + (vr + 16 * j) * AT_VLD + vc + 4) = make_uint2(gv[j][2], gv[j][3]); }
  }
  for (int i = 0; i < nblk; ++i) {
    u16* cur = lds + (i & 1) * AT_BUF;
    u16* nxt = lds + ((i + 1) & 1) * AT_BUF;
    const bool more = i + 1 < nblk;
    if (more) {
      const u16 *kb, *vb;
      pf(i + 1, kb, vb);
#pragma unroll
      for (int j = 0; j < 4; ++j) { gk[j] = *(const u32x4*)(kb + (size_t)(kr + 8 * j) * ZW + kc); gv[j] = *(const u32x4*)(vb + (size_t)(vr + 16 * j) * TOKS + vc); }
    }
    bf16x8 kf[4], vf[4];
#pragma unroll
    for (int ks = 0; ks < 4; ++ks) kf[ks] = *(const bf16x8*)(cur + r * AT_KLD + ks * 16 + h * 8);
#pragma unroll
    for (int s2 = 0; s2 < 2; ++s2) {
      union { uint2 u[2]; bf16x8 v; } va, vb2;
      const u16* v0 = cur + 32 * AT_KLD + r * AT_VLD + 16 * s2 + 4 * h;
      va.u[0] = *(const uint2*)(v0); va.u[1] = *(const uint2*)(v0 + 8);
      vb2.u[0] = *(const uint2*)(v0 + 32 * AT_VLD); vb2.u[1] = *(const uint2*)(v0 + 32 * AT_VLD + 8);
      vf[2 * s2] = va.v; vf[2 * s2 + 1] = vb2.v;
    }
    attn_compute(S, qf, kf, vf, [&](int e, float s) { return sf(i, e, s); });
    if (more) {
#pragma unroll
      for (int j = 0; j < 4; ++j) { *(u32x4*)(nxt + (kr + 8 * j) * AT_KLD + kc) = gk[j]; *(uint2*)(nxt + 32 * AT_KLD + (vr + 16 * j) * AT_VLD + vc) = make_uint2(gv[j][0], gv[j][1]); *(uint2*)(nxt + 32 * AT_KLD + (vr + 16 * j) * AT_VLD + vc + 4) = make_uint2(gv[j][2], gv[j][3]); }
    }
  }
}
DI void attn_finish(AttnSt& S, bool has_sink, float sink, u16* __restrict__ dst  ) {
  const int h = (tidx() & 63) >> 5;
  float l = S.l + __shfl_xor(S.l, 32);
  float scale;
  if (has_sink) { float mf = fmaxf(S.m, sink); float e = __expf(S.m - mf); l = l * e + __expf(sink - mf); scale = e / l; }
  else scale = 1.f / l;
#pragma unroll
  for (int g = 0; g < 4; ++g) {
    uint2 o;
    o.x = pack2(S.o0[4 * g] * scale, S.o0[4 * g + 1] * scale); o.y = pack2(S.o0[4 * g + 2] * scale, S.o0[4 * g + 3] * scale);
    *(uint2*)(dst + 8 * g + 4 * h) = o;
    o.x = pack2(S.o1[4 * g] * scale, S.o1[4 * g + 1] * scale); o.y = pack2(S.o1[4 * g + 2] * scale, S.o1[4 * g + 3] * scale);
    *(uint2*)(dst + 32 + 8 * g + 4 * h) = o;
  }
}
DI void load_q(bf16x8 (&qf)[4], const u16* __restrict__ qp) {
#pragma unroll
  for (int ks = 0; ks < 4; ++ks) qf[ks] = *(const bf16x8*)(qp + ks * 16);
}
DI void na_item(const Params& p, int l, int item, u16* lds) {
  const int lane = tidx() & 63, r = lane & 31, h = lane >> 5;
  const int half = item & 1, gr = (item >> 1) & 63, hd = (item >> 7) & 3, b = item >> 9;
  const u16* Z = (const u16*)(p.ws + OFF_ZMIX);
  const u16* vt_head = (const u16*)(p.ws + OFF_VTNA) + (size_t)(b * 256 + hd * 64) * TOKS;
  const int qc = half * 32 + r, qrow = b * 4096 + gr * 64 + qc;
  bf16x8 qf[4];
  load_q(qf, Z + (size_t)qrow * ZW + 256 + hd * 64 + h * 8);
  AttnSt S; attn_init(S);
  const int row0 = min(max(gr - 4, 0), 56);
  const int cs = min(max(qc - 8, 0), 48);
  const float* rpb = p.in[25] + (size_t)(l * 4 + hd) * 15 * 31 + (row0 - gr + 7) * 31 + 15 - qc;
  const u16* kcolb = Z + 512 + hd * 64;
  attn_run(S, qf, 24,
    [&](int i, const u16*& kb, const u16*& vb) {
      const int tok0 = i < 16 ? (row0 + (i >> 1)) * 64 + (i & 1) * 32 : 4096 + (i - 16) * 32;
      const int krow = i < 16 ? b * 4096 + tok0 : NLAT + b * 256 + (i - 16) * 32;
      kb = kcolb + (size_t)krow * ZW; vb = vt_head + tok0;
    },
    [&](int i, int e, float s) {
      if (i >= 16) return s;
      const int kc2 = (i & 1) * 32 + crow(e, h);
      const bool ok = kc2 >= cs && kc2 < cs + 16;
      return ok ? s + rpb[(i >> 1) * 31 + kc2] : -1e30f;
    }, lds);
  attn_finish(S, false, 0.f, (u16*)(p.ws + OFF_BR) + (size_t)qrow * D + 512 + hd * 64);
}
DI void sw_item(const Params& p, int l, int item, u16* lds) {
  const int lane = tidx() & 63, r = lane & 31, h = lane >> 5;
  const int qt = item & 127, qh = (item >> 7) & 3, b = item >> 9, kvh = qh >> 1;
  const u16* Z = (const u16*)(p.ws + OFF_ZMIX);
  const u16* vt_head = (const u16*)(p.ws + OFF_VTSW) + (size_t)(b * 128 + kvh * 64) * TOKS;
  const int qpos = qt * 32 + r, qrow = b * 4096 + qpos;
  bf16x8 qf[4];
  load_q(qf, Z + (size_t)qrow * ZW + 768 + qh * 64 + h * 8);
  AttnSt S; attn_init(S);
  const int kb_lo = max(qt - 4, 0), kb_hi = min(qt + 4, 127), nl = kb_hi - kb_lo + 1;
  const u16* kcolb = Z + 1024 + kvh * 64;
  attn_run(S, qf, nl + 8,
    [&](int i, const u16*& kb, const u16*& vb) {
      const int tok0 = i < nl ? (kb_lo + i) * 32 : 4096 + (i - nl) * 32;
      const int krow = i < nl ? b * 4096 + tok0 : NLAT + b * 256 + (i - nl) * 32;
      kb = kcolb + (size_t)krow * ZW; vb = vt_head + tok0;
    },
    [&](int i, int e, float s) {
      if (i >= nl) return s;
      const int d = (kb_lo + i) * 32 + crow(e, h) - qpos;
      return (d <= 128 && d >= -128) ? s : -1e30f;
    }, lds);
  attn_finish(S, true, p.in[26][l * 4 + qh], (u16*)(p.ws + OFF_BR) + (size_t)qrow * D + 768 + qh * 64);
}
DI void ctxattn_item(const Params& p, int l, int item, u16* lds) {
  const int lane = tidx() & 63, r = lane & 31, h = lane >> 5;
  const int qt = item & 7, hd = (item >> 3) & 3, b = (item >> 5) & 3, which = item >> 7;
  const u16* Z = (const u16*)(p.ws + OFF_ZMIX);
  const int qrow = NLAT + b * 256 + qt * 32 + r;
  const int kvh = hd >> 1;
  const int qcol = which == 0 ? 256 + hd * 64 : 768 + hd * 64, kcol = which == 0 ? 512 + hd * 64 : 1024 + kvh * 64;
  const u16* vt_head = which == 0 ? (const u16*)(p.ws + OFF_VTNA) + (size_t)(b * 256 + hd * 64) * TOKS
                                  : (const u16*)(p.ws + OFF_VTSW) + (size_t)(b * 128 + kvh * 64) * TOKS;
  bf16x8 qf[4];
  AttnSt S; attn_init(S);
  load_q(qf, Z + (size_t)qrow * ZW + qcol + h * 8);
  const u16* kcolb = Z + (size_t)(NLAT + b * 256) * ZW + kcol;
  attn_run(S, qf, 8,
    [&](int i, const u16*& kb, const u16*& vb) { kb = kcolb + (size_t)(i * 32) * ZW; vb = vt_head + 4096 + i * 32; },
    [&](int, int, float s) { return s; }, lds);
  attn_finish(S, which == 1, p.in[26][l * 4 + hd], (u16*)(p.ws + OFF_BR) + (size_t)qrow * D + (which == 0 ? 512 : 768) + hd * 64);
}

DI int s5_chunk_row0(int b, int cc) { return cc < 4 ? NLAT + b * 256 + cc * 64 : b * 4096 + (cc - 4) * 64; }
DI void s5_passA_item(const Params& p, int item, float* su  ) {
  const int lane = tidx() & 63;
  const int cc = item % NCHUNK; int t = item / NCHUNK; const int g = t & 15; t >>= 4; const int b = t & 3, dir = t >> 2;
  const u16* Z = (const u16*)(p.ws + OFF_ZMIX);
  const int row0 = s5_chunk_row0(b, cc);
  {
    const u16* src = Z + (size_t)(row0 + lane) * ZW + g * 16;
    uint4 q0 = *(const uint4*)src, q1 = *(const uint4*)(src + 8);
    unsigned uu[8] = {q0.x, q0.y, q0.z, q0.w, q1.x, q1.y, q1.z, q1.w};
#pragma unroll
    for (int j = 0; j < 8; ++j) { su[lane * 16 + 2 * j] = __uint_as_float(uu[j] << 16); su[lane * 16 + 2 * j + 1] = __uint_as_float(uu[j] & 0xffff0000u); }
  }
  __builtin_amdgcn_wave_barrier();
  __threadfence_block();
  const int si = (dir * 16 + g) * 64 + lane;
  const float* A = (const float*)(p.ws + OFF_S5A);
  const float are = A[si * 2], aim = A[si * 2 + 1];
  float bbr[16], bbi[16];
  {
    const float4* BB = (const float4*)((const float*)(p.ws + OFF_S5BB) + (size_t)si * 32);
#pragma unroll
    for (int j = 0; j < 8; ++j) { float4 q = BB[j]; bbr[2 * j] = q.x; bbi[2 * j] = q.y; bbr[2 * j + 1] = q.z; bbi[2 * j + 1] = q.w; }
  }
  float hr = 0.f, hi = 0.f;
  for (int i = 0; i < 64; ++i) {
    const int tt = dir ? 63 - i : i;
    float ur = 0.f, ui = 0.f;
#pragma unroll
    for (int q = 0; q < 4; ++q) {
      float4 u4 = *(const float4*)(su + tt * 16 + q * 4);
      ur += bbr[q * 4] * u4.x + bbr[q * 4 + 1] * u4.y + bbr[q * 4 + 2] * u4.z + bbr[q * 4 + 3] * u4.w;
      ui += bbi[q * 4] * u4.x + bbi[q * 4 + 1] * u4.y + bbi[q * 4 + 2] * u4.z + bbi[q * 4 + 3] * u4.w;
    }
    float nr = are * hr - aim * hi + ur, ni = are * hi + aim * hr + ui;
    hr = nr; hi = ni;
  }
  float* So = (float*)(p.ws + OFF_S5S) + ((((size_t)(dir * 4 + b) * NCHUNK + cc) * 16 + g) * 64 + lane) * 2;
  So[0] = hr; So[1] = hi;
  __builtin_amdgcn_wave_barrier();
}
DI int s5_colmap(int b, int cc) { return cc >= 4 ? b * 64 + (cc - 4) : 256 + b * 4 + cc; }
DI void s5_passB_thread(const Params& p, int i) {
  const int pp = i & 63, g = (i >> 6) & 15, b = (i >> 10) & 3, dir = i >> 12;
  const float* A = (const float*)(p.ws + OFF_S5A);
  const int si = (dir * 16 + g) * 64 + pp;
  float ar = A[si * 2], ai = A[si * 2 + 1];
  for (int k = 0; k < 6; ++k) { float nr = ar * ar - ai * ai, ni = 2.f * ar * ai; ar = nr; ai = ni; }
  const float* S = (const float*)(p.ws + OFF_S5S);
  float hr = 0.f, hi = 0.f;
  asm volatile("" : "+v"(hr), "+v"(hi));
  for (int k0 = 0; k0 < NCHUNK; k0 += 17) {
    float2 sv[17];
#pragma unroll
    for (int j = 0; j < 17; ++j) {
      const int k = k0 + j;
      const int cc = dir == 0 ? k : (k < 4 ? 3 - k : NCHUNK + 3 - k);
      sv[j] = *(const float2*)(S + ((((size_t)dir * NCOL + s5_colmap(b, cc)) * 16 + g) * 64 + pp) * 2);
    }
#pragma unroll
    for (int j = 0; j < 17; ++j) {
      const int k = k0 + j;
      const int cc = dir == 0 ? k : (k < 4 ? 3 - k : NCHUNK + 3 - k);
      *(unsigned*)((u16*)(p.ws + OFF_HB) + ((size_t)g * NCOL + s5_colmap(b, cc)) * 256 + dir * 128 + pp * 2) = pack2(hr, hi);
      float nr = ar * hr - ai * hi + sv[j].x, ni = ar * hi + ai * hr + sv[j].y;
      hr = nr; hi = ni;
    }
  }
}
DI void s5_passC_item(const Params& p, int l, int b, int g, int cc, char* smem) {
  const int tid = tidx();
  float* su = (float*)smem;
  float* ys = su + 1024;
  float* cre = ys + 1024;
  float* cim = cre + 2 * 16 * 65;
  float* hre = cim + 2 * 16 * 65;
  float* him = hre + 2 * 16 * 65;
  const u16* Z = (const u16*)(p.ws + OFF_ZMIX);
  const int row0 = s5_chunk_row0(b, cc);
  for (int e = tid; e < 1024; e += 256) { su[e] = bf2f(Z[(size_t)(row0 + (e >> 4)) * ZW + g * 16 + (e & 15)]); ys[e] = 0.f; }
  for (int e = tid; e < 2048; e += 256) {
    int dir = e >> 10, n = (e >> 6) & 15, pp = e & 63;
    size_t gi = ((((size_t)l * 2 + dir) * 16 + g) * 16 + n) * 64 + pp;
    cre[(dir * 16 + n) * 65 + pp] = p.in[12][gi];
    cim[(dir * 16 + n) * 65 + pp] = p.in[13][gi];
  }
  __syncthreads();
  float are = 0, aim = 0, hr = 0, hi = 0;
  float bbr[16], bbi[16];
  const int sdir = (tid >> 6) & 1, spp = tid & 63;
  if (tid < 128) {
    const int si = (sdir * 16 + g) * 64 + spp;
    const float* A = (const float*)(p.ws + OFF_S5A);
    are = A[si * 2]; aim = A[si * 2 + 1];
    const float4* BB = (const float4*)((const float*)(p.ws + OFF_S5BB) + (size_t)si * 32);
#pragma unroll
    for (int j = 0; j < 8; ++j) { float4 q = BB[j]; bbr[2 * j] = q.x; bbi[2 * j] = q.y; bbr[2 * j + 1] = q.z; bbi[2 * j + 1] = q.w; }
    const float* Hh = (const float*)(p.ws + OFF_S5H) + ((((size_t)(sdir * 4 + b) * NCHUNK + cc) * 16 + g) * 64 + spp) * 2;
    hr = Hh[0]; hi = Hh[1];
  } else {
#pragma unroll
    for (int j = 0; j < 16; ++j) { bbr[j] = 0.f; bbi[j] = 0.f; }
  }
  for (int sub = 0; sub < 4; ++sub) {
    if (tid < 128) {
      for (int i = 0; i < 16; ++i) {
        const int tt = sdir ? 63 - (sub * 16 + i) : sub * 16 + i;
        float ur = 0.f, ui = 0.f;
#pragma unroll
        for (int q = 0; q < 4; ++q) {
          float4 u4 = *(const float4*)(su + tt * 16 + q * 4);
          ur += bbr[q * 4] * u4.x + bbr[q * 4 + 1] * u4.y + bbr[q * 4 + 2] * u4.z + bbr[q * 4 + 3] * u4.w;
          ui += bbi[q * 4] * u4.x + bbi[q * 4 + 1] * u4.y + bbi[q * 4 + 2] * u4.z + bbi[q * 4 + 3] * u4.w;
        }
        float nr = are * hr - aim * hi + ur, ni = are * hi + aim * hr + ui;
        hr = nr; hi = ni;
        hre[(sdir * 16 + i) * 65 + spp] = hr;
        him[(sdir * 16 + i) * 65 + spp] = hi;
      }
    }
    __syncthreads();
    {
      const int dir = tid >> 7, i = (tid >> 3) & 15, n = tid & 7;
      const float* hrp = hre + (dir * 16 + i) * 65;
      const float* hip_ = him + (dir * 16 + i) * 65;
      const float* c0r = cre + (dir * 16 + n) * 65;
      const float* c0i = cim + (dir * 16 + n) * 65;
      const float* c1r = c0r + 8 * 65;
      const float* c1i = c0i + 8 * 65;
      float y0 = 0.f, y1 = 0.f;
#pragma unroll 8
      for (int pp = 0; pp < 64; ++pp) {
        float a = hrp[pp], bq = hip_[pp];
        y0 += c0r[pp] * a - c0i[pp] * bq;
        y1 += c1r[pp] * a - c1i[pp] * bq;
      }
      const int tt = dir ? 63 - (sub * 16 + i) : sub * 16 + i;
      ys[tt * 16 + n] += y0;
      ys[tt * 16 + n + 8] += y1;
    }
    __syncthreads();
  }
  const float* dd = p.in[14] + l * 256 + g * 16;
  u16* G = (u16*)(p.ws + OFF_S5G);
  for (int e = tid; e < 1024; e += 256) {
    int tt = e >> 4, n = e & 15;
    float y = ys[e] + dd[n] * su[e];
    G[(size_t)(row0 + tt) * 256 + g * 16 + n] = f2bf(gelu_tanh(y));
  }
  __syncthreads();
}


DI void s5_disc_compute(const Params& p, int l, int si  , float& lm, float& th, float& f_re, float& f_im) {
  const int dir = si >> 10, g = (si >> 6) & 15;
  const float lre = p.in[7][l * 2048 + si], lim = p.in[8][l * 2048 + si];
  const float dt = __expf(p.in[9][(l * 2 + dir) * 16 + g]);
  lm = lre * dt; th = lim * dt;
  float sn, cs; sincosf(th, &sn, &cs);
  const float em1 = expm1f(lm), mag = em1 + 1.f;
  const float a_im = mag * sn;
  const float sh = sinf(0.5f * th);
  const float are_m1 = em1 * cs - 2.f * sh * sh;
  const float den = lre * lre + lim * lim;
  f_re = (are_m1 * lre + a_im * lim) / den; f_im = (a_im * lre - are_m1 * lim) / den;
}
DI void s5_disc(const Params& p, int l, int si, float& lm, float& th, float& f_re, float& f_im) {
  const float4 v = *(const float4*)((const float*)(p.ws + OFF_S5D) + ((size_t)l * 2048 + si) * 4);
  lm = v.x; th = v.y; f_re = v.z; f_im = v.w;
}
DI void s5_cpow(float lm, float th, int k, float& re, float& im) {
  const float x = th * (float)k;
  const float sn = __sinf(x), cs = __cosf(x);
  const float mg = __expf(lm * (float)k);
  re = mg * cs; im = mg * sn;
}
DI void s5_k2_thread(const Params& p, int l, int idx) {
  const int tb = idx & 7, m = (idx >> 3) & 15, n = (idx >> 7) & 15, d = (idx >> 11) & 1, g = idx >> 12;
  float acc[8];
#pragma unroll
  for (int e = 0; e < 8; ++e) acc[e] = 0.f;
  float extra = 0.f;
  for (int pp = 0; pp < 64; ++pp) {
    const int si = (d * 16 + g) * 64 + pp;
    float lm, th, fr, fi; s5_disc(p, l, si, lm, th, fr, fi);
    const float br = p.in[10][((size_t)l * 2048 + si) * 16 + m], bi = p.in[11][((size_t)l * 2048 + si) * 16 + m];
    const float bbr = fr * br - fi * bi, bbi = fr * bi + fi * br;
    const size_t ci = ((((size_t)l * 2 + d) * 16 + g) * 16 + n) * 64 + pp;
    const float cr = p.in[12][ci], cim = p.in[13][ci];
    float wr = cr * bbr - cim * bbi, wi = cr * bbi + cim * bbr;
    float pr, pi; s5_cpow(lm, th, tb * 8, pr, pi);
    float ar, ai; s5_cpow(lm, th, 1, ar, ai);
    float xr = wr * pr - wi * pi, xi = wr * pi + wi * pr;
#pragma unroll
    for (int e = 0; e < 8; ++e) { acc[e] += xr; float nr = xr * ar - xi * ai, ni = xr * ai + xi * ar; xr = nr; xi = ni; }
    if (d == 0 && tb == 0) {
      const int s1 = (16 + g) * 64 + pp;
      float lm1, th1, fr1, fi1; s5_disc(p, l, s1, lm1, th1, fr1, fi1);
      const float br1 = p.in[10][((size_t)l * 2048 + s1) * 16 + m], bi1 = p.in[11][((size_t)l * 2048 + s1) * 16 + m];
      const float b1r = fr1 * br1 - fi1 * bi1, b1i = fr1 * bi1 + fi1 * br1;
      const size_t c1 = ((((size_t)l * 2 + 1) * 16 + g) * 16 + n) * 64 + pp;
      extra += p.in[12][c1] * b1r - p.in[13][c1] * b1i;
    }
  }
  u16* K2 = (u16*)(p.ws + OFF_K2) + (size_t)g * 127 * 256 + n * 16 + m;
  if (d == 0 && tb == 0) acc[0] += extra + (n == m ? p.in[14][l * 256 + g * 16 + n] : 0.f);
#pragma unroll
  for (int e = 0; e < 8; ++e) {
    const int k = tb * 8 + e;
    if (d == 0) K2[(size_t)(63 + k) * 256] = f2bf(acc[e]);
    else if (k > 0) K2[(size_t)(63 - k) * 256] = f2bf(acc[e]);
  }
}
DI void s5_pe_thread(const Params& p, int l, int idx) {
  const int sx = idx & 63, pp = (idx >> 6) & 63, d = (idx >> 12) & 1, g = idx >> 13;
  const int si = (d * 16 + g) * 64 + pp;
  float lm, th, fr, fi; s5_disc(p, l, si, lm, th, fr, fi);
  float qr, qi; s5_cpow(lm, th, d == 0 ? 63 - sx : sx, qr, qi);
  u16* P0 = (u16*)(p.ws + OFF_PT) + ((size_t)g * 256 + d * 128 + pp * 2) * 1024 + sx * 16;
  const float* bre = p.in[10] + ((size_t)l * 2048 + si) * 16;
  const float* bim = p.in[11] + ((size_t)l * 2048 + si) * 16;
  unsigned pr_[8], pi_[8];
#pragma unroll
  for (int m2 = 0; m2 < 8; ++m2) {
    float vr[2], vi[2];
#pragma unroll
    for (int q = 0; q < 2; ++q) {
      const float br = bre[2 * m2 + q], bi = bim[2 * m2 + q];
      const float bbr = fr * br - fi * bi, bbi = fr * bi + fi * br;
      vr[q] = qr * bbr - qi * bbi; vi[q] = qr * bbi + qi * bbr;
    }
    pr_[m2] = pack2(vr[0], vr[1]); pi_[m2] = pack2(vi[0], vi[1]);
  }
  *(uint4*)(P0) = make_uint4(pr_[0], pr_[1], pr_[2], pr_[3]); *(uint4*)(P0 + 8) = make_uint4(pr_[4], pr_[5], pr_[6], pr_[7]);
  *(uint4*)(P0 + 1024) = make_uint4(pi_[0], pi_[1], pi_[2], pi_[3]); *(uint4*)(P0 + 1024 + 8) = make_uint4(pi_[4], pi_[5], pi_[6], pi_[7]);
  float er, ei; s5_cpow(lm, th, d == 0 ? sx + 1 : 64 - sx, er, ei);
  u16* E0 = (u16*)(p.ws + OFF_ET) + ((size_t)g * 1024 + sx * 16) * 256 + d * 128 + pp * 2;
#pragma unroll
  for (int n = 0; n < 16; ++n) {
    const size_t ci = ((((size_t)l * 2 + d) * 16 + g) * 16 + n) * 64 + pp;
    const float cr = p.in[12][ci], cim = p.in[13][ci];
    *(unsigned*)(E0 + (size_t)n * 256) = pack2(cr * er - cim * ei, -(cr * ei + cim * er));
  }
}
DI int s5_col_row0(int col) { return col < 256 ? (col >> 6) * 4096 + (col & 63) * 64 : NLAT + ((col - 256) >> 2) * 256 + ((col - 256) & 3) * 64; }
struct S5UFn {
  const u16* base[2];
  DI S5UFn(const Params& p, int g, int n0) {
    const int tid = tidx(), lrow = tid >> 3, lch = tid & 7;
#pragma unroll
    for (int i = 0; i < 2; ++i) {
      const int col = min(n0 + lrow + 32 * i, NCOL - 1);
      base[i] = (const u16*)(p.ws + OFF_ZMIX) + (size_t)(s5_col_row0(col) + (lch >> 1)) * ZW + g * 16 + (lch & 1) * 8;
    }
  }
  DI const u16* operator()(int i, int kt) const { return base[i] + (size_t)kt * 4 * ZW; }
};
DI void s5_state_tile(const Params& p, int g, int mt, int nt, char* smem) {
  const int tid = tidx(), lane = tid & 63, w = tid >> 6, r = lane & 31, h = lane >> 5, lrow = tid >> 3, lch = tid & 7;
  const int m0 = mt * 128, n0 = nt * 64;
  f32x16 acc[2][1]; zero_acc<1>(acc);
  const u16* ga = (const u16*)(p.ws + OFF_PT) + ((size_t)g * 256 + m0 + lrow) * 1024 + lch * 8;
  S5UFn fb(p, g, n0);
  gemm_acc_f<1>([=](int i, int kt) { return ga + (size_t)i * 32 * 1024 + kt * 64; }, fb, 16, acc, (u16*)smem);
  float* S = (float*)(p.ws + OFF_S5S);
  const int col = n0 + (w & 1) * 32 + r;
  if (col < NCOL) {
#pragma unroll
    for (int a = 0; a < 2; ++a)
#pragma unroll
      for (int i = 0; i < 16; ++i) {
        const int dpr = m0 + (w >> 1) * 64 + a * 32 + crow(i, h);
        S[(((size_t)(dpr >> 7) * NCOL + col) * 16 + g) * 128 + (dpr & 127)] = acc[a][0][i];
      }
  }
}
DI void s5_out_tile(const Params& p, int g, int mt, int nt, char* smem) {
  const int tid = tidx(), lane = tid & 63, w = tid >> 6, r = lane & 31, h = lane >> 5, lrow = tid >> 3, lch = tid & 7;
  const int m0 = mt * 128, n0 = nt * 64;
  f32x16 acc[2][1]; zero_acc<1>(acc);
  S5UFn fb(p, g, n0);
  {
    const u16* k2 = (const u16*)(p.ws + OFF_K2) + (size_t)g * 127 * 256 + (lch & 1) * 8;
    const int rr = m0 + lrow, t0 = rr >> 4, n = rr & 15;
    const u16* ka = k2 + ((size_t)(t0 - (lch >> 1) + 63) * 16 + n) * 16;
    gemm_acc_f<1>([=](int i, int kt) { return ka + (ptrdiff_t)(2 * i - 4 * kt) * 256; }, fb, 16, acc, (u16*)smem);
  }
  {
    const u16* ga = (const u16*)(p.ws + OFF_ET) + ((size_t)g * 1024 + m0 + lrow) * 256 + lch * 8;
    const u16* hb = (const u16*)(p.ws + OFF_HB) + (size_t)g * NCOL * 256 + lch * 8;
    const int c0 = min(n0 + lrow, NCOL - 1), c1 = min(n0 + lrow + 32, NCOL - 1);
    const u16* gb0 = hb + (size_t)c0 * 256;
    const u16* gb1 = hb + (size_t)c1 * 256;
    gemm_acc_f<1>([=](int i, int kt) { return ga + (size_t)i * 32 * 256 + kt * 64; },
                  [=](int i, int kt) { return (i == 0 ? gb0 : gb1) + kt * 64; }, 4, acc, (u16*)smem);
  }
  const int col = n0 + (w & 1) * 32 + r;
  if (col < NCOL) {
    u16* G = (u16*)(p.ws + OFF_S5G) + (size_t)s5_col_row0(col) * 256 + g * 16;
#pragma unroll
    for (int a = 0; a < 2; ++a)
#pragma unroll
      for (int q = 0; q < 4; ++q) {
        const int tn = m0 + (w >> 1) * 64 + a * 32 + 8 * q + 4 * h;
        uint2 o;
        o.x = pack2(gelu_tanh(acc[a][0][4 * q]), gelu_tanh(acc[a][0][4 * q + 1]));
        o.y = pack2(gelu_tanh(acc[a][0][4 * q + 2]), gelu_tanh(acc[a][0][4 * q + 3]));
        *(uint2*)(G + (size_t)(tn >> 4) * 256 + (tn & 15)) = o;
      }
  }
}

constexpr int HY_E = 0, HY_O = 16384 + 64, HY_U = 32896;
DI void hyena_mfma_item(const Params& p, int l, int order, int c, int half, char* smem) {
  const int tid = tidx(), lane = tid & 63, w = tid >> 6, r = lane & 31, h = lane >> 5;
  {
    const u16* FR = (const u16*)(p.ws + OFF_FILTR) + ((size_t)order * 256 + c) * 8192;
#pragma unroll
    for (int ci = tid; ci < 1024; ci += 256) {
      uint4 q = *(const uint4*)(FR + ci * 8);
      unsigned nx = ci < 1023 ? *(const unsigned*)(FR + ci * 8 + 8) : 0u;
      *(uint4*)(smem + HY_E + ci * 16) = q;
      uint4 o; o.x = (q.x >> 16) | (q.y << 16); o.y = (q.y >> 16) | (q.z << 16); o.z = (q.z >> 16) | (q.w << 16); o.w = (q.w >> 16) | (nx << 16);
      *(uint4*)(smem + HY_O + ci * 16) = o;
    }
  }
  {
    unsigned zz = 0;
    asm volatile("" : "+v"(zz));
    for (int e = tid; e < 448; e += 256) {
      int J = e >> 3; int Jb = J < 28 ? J : J + 256;
      *(uint4*)(smem + HY_U + Jb * 128 + (e & 7) * 16) = make_uint4(zz, zz, zz, zz);
    }
  }
  const float* cw = p.in[16] + (size_t)l * 3 * 768;
  const float* cb = p.in[17] + (size_t)l * 768;
  {
    const float w0 = cw[c], w1 = cw[768 + c], w2 = cw[1536 + c], wb = cb[c];
#pragma unroll
    for (int e = tid; e < 2048; e += 256) {
      const int b = e >> 9, ch = e & 511, t0 = ch * 8;
      uint4 val;
      if (order == 0) {
        const u16* src = (const u16*)(p.ws + OFF_HYT) + ((size_t)(b * 768 + c)) * TOKS;
        uint4 q = *(const uint4*)(src + t0);
        float z[10];
        z[0] = t0 > 0 ? bf2f(src[t0 - 1]) : 0.f;
        z[9] = t0 + 8 < 4096 ? bf2f(src[t0 + 8]) : 0.f;
        unsigned uu[4] = {q.x, q.y, q.z, q.w};
#pragma unroll
        for (int k = 0; k < 4; ++k) { z[1 + 2 * k] = __uint_as_float(uu[k] << 16); z[2 + 2 * k] = __uint_as_float(uu[k] & 0xffff0000u); }
        float u[8];
#pragma unroll
        for (int k = 0; k < 8; ++k) u[k] = w0 * z[k] + w1 * z[k + 1] + w2 * z[k + 2] + wb;
        val.x = pack2(u[0], u[1]); val.y = pack2(u[2], u[3]); val.z = pack2(u[4], u[5]); val.w = pack2(u[6], u[7]);
      } else {
        val = *(const uint4*)((const u16*)(p.ws + OFF_HYV1) + ((size_t)(b * 256 + c)) * TOKS + t0);
      }
      const int J = ((ch >> 3) + 7) * 4 + b, q8 = ch & 7;
      *(uint4*)(smem + HY_U + J * 128 + ((q8 ^ ((J >> 1) & 7)) << 4)) = val;
    }
  }
  __syncthreads();
  const int i0 = half * 32 + w * 8, il = r >> 2, bt = r & 3;
  f32x16 acc0, acc1;
#pragma unroll
  for (int i = 0; i < 16; ++i) { acc0[i] = 0.f; acc1[i] = 0.f; }
  const int fbase = ((r & 1) ? HY_E + ((4095 - r) >> 1) * 4 : HY_O + ((4094 - r) >> 1) * 4) + h * 16;
  for (int d = i0 - 63; d <= i0 + 7; ++d) {
    const int J = (i0 + il - d + 7) * 4 + bt;
    const char* ub = smem + HY_U + J * 128;
    const int key = (J >> 1) & 7;
    const char* fb = smem + fbase - 128 * d;
    bf16x8 fr[6];
#pragma unroll
    for (int k = 0; k < 6; ++k) {
      const unsigned* q = (const unsigned*)(fb - 32 * (k - 3));
      union { unsigned u[4]; bf16x8 v; } t;
      t.u[0] = q[0]; t.u[1] = q[1]; t.u[2] = q[2]; t.u[3] = q[3];
      fr[k] = t.v;
    }
#pragma unroll
    for (int ks = 0; ks < 4; ++ks) {
      bf16x8 bf = *(const bf16x8*)(ub + (((2 * ks + h) ^ key) << 4));
      acc0 = MFMA32(fr[3 - ks], bf, acc0);
      acc1 = MFMA32(fr[5 - ks], bf, acc1);
    }
  }
  const int gc = (order + 1) * 256 + c;
  const float g0 = cw[gc], g1 = cw[768 + gc], g2 = cw[1536 + gc], gb = cb[gc];
  const u16* zs = (const u16*)(p.ws + OFF_HYT) + ((size_t)(bt * 768 + gc)) * TOKS;
  u16* dst = (u16*)(p.ws + (order == 0 ? OFF_HYV1 : OFF_HYO)) + ((size_t)(bt * 256 + c)) * TOKS;
#pragma unroll
  for (int m = 0; m < 2; ++m)
#pragma unroll
    for (int g = 0; g < 4; ++g) {
      const int t = 64 * (i0 + il) + 32 * m + 8 * g + 4 * h;
      uint2 q = *(const uint2*)(zs + t);
      float z[6];
      z[0] = t > 0 ? bf2f(zs[t - 1]) : 0.f;
      z[5] = t + 4 < 4096 ? bf2f(zs[t + 4]) : 0.f;
      z[1] = __uint_as_float(q.x << 16); z[2] = __uint_as_float(q.x & 0xffff0000u);
      z[3] = __uint_as_float(q.y << 16); z[4] = __uint_as_float(q.y & 0xffff0000u);
      float o[4];
#pragma unroll
      for (int k = 0; k < 4; ++k) {
        float gate = g0 * z[k] + g1 * z[k + 1] + g2 * z[k + 2] + gb;
        o[k] = gate * (m == 0 ? acc0[4 * g + k] : acc1[4 * g + k]);
      }
      uint2 ov; ov.x = pack2(o[0], o[1]); ov.y = pack2(o[2], o[3]);
      *(uint2*)(dst + t) = ov;
    }
  __syncthreads();
}
DI void hyena_ctx_item(const Params& p, int l, int order, int b, int c, char* smem) {
  const int t = tidx();
  float* su = (float*)smem;
  float* sk = su + 256;
  const float* cw = p.in[16] + (size_t)l * 3 * 768;
  const float* cb = p.in[17] + (size_t)l * 768;
  const u16* zv = (const u16*)(p.ws + OFF_HYT) + ((size_t)(b * 768 + c)) * TOKS + 4096;
  if (order == 0) {
    float zl = t > 0 ? bf2f(zv[t - 1]) : 0.f, zc = bf2f(zv[t]), zr = t < 255 ? bf2f(zv[t + 1]) : 0.f;
    su[t] = bf2f(f2bf(cw[c] * zl + cw[768 + c] * zc + cw[1536 + c] * zr + cb[c]));
  } else {
    su[t] = bf2f(((const u16*)(p.ws + OFF_HYV1))[((size_t)(b * 256 + c)) * TOKS + 4096 + t]);
  }
  const float* FC = (const float*)(p.ws + OFF_FCTX) + ((size_t)order * 256 + c) * 512;
  sk[t] = t > 0 ? FC[t] : 0.f;
  sk[256 + t] = FC[256 + t];
  __syncthreads();
  float acc = 0.f;
#pragma unroll 8
  for (int s = 0; s < 256; ++s) acc += sk[t - s + 256] * su[s];
  const int gc = (order + 1) * 256 + c;
  const u16* zg = (const u16*)(p.ws + OFF_HYT) + ((size_t)(b * 768 + gc)) * TOKS + 4096;
  float zl = t > 0 ? bf2f(zg[t - 1]) : 0.f, zc = bf2f(zg[t]), zr = t < 255 ? bf2f(zg[t + 1]) : 0.f;
  float gate = cw[gc] * zl + cw[768 + gc] * zc + cw[1536 + gc] * zr + cb[gc];
  u16* dst = (u16*)(p.ws + (order == 0 ? OFF_HYV1 : OFF_HYO)) + ((size_t)(b * 256 + c)) * TOKS + 4096;
  dst[t] = f2bf(gate * acc);
  __syncthreads();
}
DI void hyena_transpose_item(const Params& p, int b, int ct, int tt, char* smem) {
  const int tid = tidx();
  u16* tile = (u16*)smem;
  const u16* src = (const u16*)(p.ws + OFF_HYO) + ((size_t)(b * 256 + ct * 64)) * TOKS + tt * 64;
  for (int e = tid; e < 2048; e += 256) {
    int cc = e >> 5, t2 = (e & 31) * 2;
    *(unsigned*)(tile + cc * 66 + t2) = *(const unsigned*)(src + (size_t)cc * TOKS + t2);
  }
  __syncthreads();
  const int rowb = tt < 64 ? b * 4096 + tt * 64 : NLAT + b * 256 + (tt - 64) * 64;
  u16* BR = (u16*)(p.ws + OFF_BR);
  for (int e = tid; e < 2048; e += 256) {
    int tk = e >> 5, c2 = (e & 31) * 2;
    unsigned v = (unsigned)tile[c2 * 66 + tk] | ((unsigned)tile[(c2 + 1) * 66 + tk] << 16);
    *(unsigned*)(BR + (size_t)(rowb + tk) * D + 256 + ct * 64 + c2) = v;
  }
  __syncthreads();
}


template <int NI, class EPI>
DI void for_acc(f32x16 (&acc)[2][NI], int m0, int n0, EPI epi) {
  const int lane = tidx() & 63, w = tidx() >> 6, r = lane & 31, h = lane >> 5;
#pragma unroll
  for (int mi = 0; mi < 2; ++mi)
#pragma unroll
    for (int ni = 0; ni < NI; ++ni)
#pragma unroll
      for (int i = 0; i < 16; ++i) epi(m0 + (w >> 1) * 64 + mi * 32 + crow(i, h), n0 + (w & 1) * 32 * NI + ni * 32 + r, acc[mi][ni][i]);
}
template <int NI>
DI void wout_tile(const Params& p, int l, int m0, int n0, char* smem) {
  f32x16 acc[2][NI]; zero_acc<NI>(acc);
  gemm_acc<NI>((const u16*)(p.ws + OFF_MERGED) + (size_t)m0 * D, D, (const u16*)(p.ws + OFF_WO) + (size_t)n0 * D, D, 1024, acc, (u16*)smem);
  const float* gav = modp(p, l, bidx_of_row(m0), 2);
  float* xo = xrow(p, m0);
  const float* xi = xin_row(p, l, m0);
  for_acc<NI>(acc, 0, n0, [&](int row, int col, float v) {
    xo[(size_t)row * D + col] = ALPHA * xi[(size_t)row * D + col] + gav[col] * v;
  });
}
template <int NI>
DI void mlp2_tile(const Params& p, int l, int m0, int n0, char* smem) {
  f32x16 acc[2][NI]; zero_acc<NI>(acc);
  gemm_acc<NI>((const u16*)(p.ws + OFF_HID) + (size_t)m0 * 4096, 4096, (const u16*)(p.ws + OFF_W2) + (size_t)n0 * 4096, 4096, 4096, acc, (u16*)smem);
  const float* gmv = modp(p, l, bidx_of_row(m0), 5);
  float* xo = xrow(p, m0);
  for_acc<NI>(acc, 0, n0, [&](int row, int col, float v) {
    float* xp = xo + (size_t)row * D + col;
    *xp = ALPHA * (*xp) + gmv[col] * v;
  });
}
template <int NI>
DI void merge_tile(const Params& p, int m0, int n0, char* smem) {
  const u16* H = (const u16*)(p.ws + OFF_H);
  const u16* BR = (const u16*)(p.ws + OFF_BR);
  const u16* WG = (const u16*)(p.ws + OFF_WIN) + (size_t)2304 * D;
  const u16* WB = (const u16*)(p.ws + OFF_WBR);
  u16* M = (u16*)(p.ws + OFF_MERGED);
  unsigned amp[2][NI][8];
#pragma unroll
  for (int a = 0; a < 2; ++a)
#pragma unroll
    for (int b2 = 0; b2 < NI; ++b2)
#pragma unroll
      for (int i = 0; i < 8; ++i) amp[a][b2][i] = 0u;
  for (int nb = 0; nb < 4; ++nb) {
    f32x16 ag[2][NI]; zero_acc<NI>(ag);
    gemm_acc<NI>(H + (size_t)m0 * D, D, WG + (size_t)(nb * 1024 + n0) * D, D, 1024, ag, (u16*)smem);
    unsigned sg[2][NI][8];
#pragma unroll
    for (int a = 0; a < 2; ++a)
#pragma unroll
      for (int b2 = 0; b2 < NI; ++b2)
#pragma unroll
        for (int i = 0; i < 8; ++i) sg[a][b2][i] = pack2(sigmoidf_(ag[a][b2][2 * i]), sigmoidf_(ag[a][b2][2 * i + 1]));
    zero_acc<NI>(ag);
    {
      const int lrow = tidx() >> 3, lch = tidx() & 7;
      const u16* ga = BR + (size_t)(m0 + lrow) * D + nb * 256 + lch * 8;
      const u16* gb = WB + (size_t)(nb * 1024 + n0 + lrow) * 256 + lch * 8;
      gemm_acc_f1<NI>([=](int i, int kt) { return ga + (size_t)i * 32 * D + kt * 64; },
                      [=](int i, int kt) { return gb + (size_t)i * 32 * 256 + kt * 64; }, 4, ag, (u16*)smem);
    }
#pragma unroll
    for (int a = 0; a < 2; ++a)
#pragma unroll
      for (int b2 = 0; b2 < NI; ++b2)
#pragma unroll
        for (int i = 0; i < 8; ++i) {
          const float lo = __uint_as_float(amp[a][b2][i] << 16) + __uint_as_float(sg[a][b2][i] << 16) * ag[a][b2][2 * i];
          const float hi2 = __uint_as_float(amp[a][b2][i] & 0xffff0000u) + __uint_as_float(sg[a][b2][i] & 0xffff0000u) * ag[a][b2][2 * i + 1];
          amp[a][b2][i] = pack2(lo, hi2);
        }
  }
  const int lane = tidx() & 63, w = tidx() >> 6, r = lane & 31, h = lane >> 5;
#pragma unroll
  for (int a = 0; a < 2; ++a)
#pragma unroll
    for (int b2 = 0; b2 < NI; ++b2)
#pragma unroll
      for (int i = 0; i < 8; ++i) {
        const int col = n0 + (w & 1) * 32 * NI + b2 * 32 + r;
        const int row0_ = m0 + (w >> 1) * 64 + a * 32;
        M[(size_t)(row0_ + crow(2 * i, h)) * D + col] = (u16)(amp[a][b2][i] & 0xffffu);
        M[(size_t)(row0_ + crow(2 * i + 1, h)) * D + col] = (u16)(amp[a][b2][i] >> 16);
      }
}
template <class F2, class F1>
DI void n1024_items(bool last, F2 full, F1 half) {
  const int nhalf = last ? 0 : 128;
  const bool swz = gridDim.x == 512;
  for (int it = blockIdx.x; it < 1024 + nhalf; it += gridDim.x) {
    const bool isfull = it < 1024;
    const int b = it & 511, x = b & 7, j = b >> 3;
    int m, n;
    if (swz) { m = isfull ? ((it >> 9) * 8 + x) * 8 + (j >> 3) : 128 + x; n = isfull ? (j & 7) : j; }
    else { m = isfull ? (it >> 3) : 128 + ((it - 1024) >> 4); n = isfull ? (it & 7) : ((it - 1024) & 15); }
    if (isfull) full(m * 128, n * 128); else half(m * 128, n * 64);
  }
}

DI void run_phase(const Params& p0, int ph, char* smem) {
  Params p = p0;
  {
    size_t z = 0;
    asm volatile("" : "+s"(z));
#pragma unroll
    for (int i = 0; i < 35; ++i) p.in[i] = p0.in[i] + z;
    p.out = p0.out + z;
    p.ws = p0.ws + z;
  }
  const int tid = tidx(), w = tid >> 6;
  if (ph == 0) { phase_mod(p, smem); phase_prep(p, 0, smem, true, false, false); return; }
  const int l = (ph - 1) / 12, k = (ph - 1) % 12;
  const bool last = (l == 1);
  const int mtiles = last ? 128 : 136;
  switch (k) {
    case 0: phase_prep(p, l, smem, l != 0, l == 0, true); break;
    case 1: phase_inproj(p, l, smem); break;
    case 2: {
      for (int it = blockIdx.x; it < 160; it += gridDim.x) s5_state_tile(p, it / 10, (it % 10) / 5, it % 5, smem);
      {
        const int nHy = 512 + (last ? 0 : 1024);
        for (int it = blockIdx.x; it < nHy; it += gridDim.x) {
          const int it2 = nHy - 1 - it;
          if (it2 < 512) hyena_mfma_item(p, l, 0, it2 >> 1, it2 & 1, smem);
          else hyena_ctx_item(p, l, 0, (it2 - 512) >> 8, (it2 - 512) & 255, smem);
        }
      }
      const int nCA = last ? 0 : 256, u = blockIdx.x * 4 + w, nslots = gridDim.x * 4;
      for (int it = u; it < 4096; it += nslots) {
        if (it < 2048) na_item(p, l, it, (u16*)smem + w * 2 * AT_BUF);
        else sw_item(p, l, it - 2048, (u16*)smem + w * 2 * AT_BUF);
      }
      for (int c = nslots - 1 - u; c < nCA; c += nslots) ctxattn_item(p, l, c, (u16*)smem + w * 2 * AT_BUF);
    } break;
    case 3: {
      for (int i = blockIdx.x * 256 + tid; i < 8192; i += gridDim.x * 256) s5_passB_thread(p, i);
      const int nHy = 512 + (last ? 0 : 1024);
      for (int it = blockIdx.x; it < nHy; it += gridDim.x) {
        const int it2 = nHy - 1 - it;
        if (it2 < 512) hyena_mfma_item(p, l, 1, it2 >> 1, it2 & 1, smem);
        else hyena_ctx_item(p, l, 1, (it2 - 512) >> 8, (it2 - 512) & 255, smem);
      }
    } break;
    case 4: {
      const int nnt = last ? 4 : 5, per_g = 8 * nnt;
      for (int it = blockIdx.x; it < 16 * per_g; it += gridDim.x) s5_out_tile(p, it / per_g, (it % per_g) / nnt, it % nnt, smem);
      const int ntt = last ? 64 : 68;
      for (int it = blockIdx.x; it < 16 * ntt; it += gridDim.x) {
        const int it2 = 16 * ntt - 1 - it;
        hyena_transpose_item(p, (it2 / ntt) >> 2, (it2 / ntt) & 3, it2 % ntt, smem);
      }
    } break;
    case 5: {
      const u16* G = (const u16*)(p.ws + OFF_S5G);
      u16* BR = (u16*)(p.ws + OFF_BR);
      for (int tile = blockIdx.x; tile < mtiles * 2; tile += gridDim.x) {
        const int m0 = (tile >> 1) * 128, n0 = (tile & 1) * 128;
        f32x16 acc[2][2]; zero_acc<2>(acc);
        gemm_acc<2>(G + (size_t)m0 * 256, 256, (const u16*)(p.ws + OFF_WGLU) + (size_t)n0 * 256, 256, 256, acc, (u16*)smem);
        FOR_ACC(acc, m0, n0, { float gg = bf2f(G[(size_t)row * 256 + col]); BR[(size_t)row * D + col] = f2bf(gg * sigmoidf_(v)); })
      }
    } break;
    case 6:
      n1024_items(last, [&](int m0, int n0) { merge_tile<2>(p, m0, n0, smem); }, [&](int m0, int n0) { merge_tile<1>(p, m0, n0, smem); });
      break;
    case 7:
      n1024_items(last, [&](int m0, int n0) { wout_tile<2>(p, l, m0, n0, smem); }, [&](int m0, int n0) { wout_tile<1>(p, l, m0, n0, smem); });
      break;
    case 8: {
      const int nrows = mtiles * 128, rs = gridDim.x * 4;
      float v[16], vn[16];
      int r = blockIdx.x * 4 + w;
      if (r < nrows) ln_load(xrow(p, r), vn);
      for (; r < nrows; r += rs) {
#pragma unroll
        for (int i = 0; i < 16; ++i) v[i] = vn[i];
        if (r + rs < nrows) ln_load(xrow(p, r + rs), vn);
        float* xr = xrow(p, r);
        ln_norm(v);
        ln_affine(v, p.in[29] + l * D, p.in[30] + l * D);
        ln_store_f32(v, xr);
        ln_norm(v);
        int bi = bidx_of_row(r);
        ln_store_mod(v, modp(p, l, bi, 3), modp(p, l, bi, 4), (u16*)(p.ws + OFF_H) + (size_t)r * D);
      }
    } break;
    case 9: {
      const u16* H = (const u16*)(p.ws + OFF_H);
      u16* HID = (u16*)(p.ws + OFF_HID);
      for (int tile = blockIdx.x; tile < mtiles * 32; tile += gridDim.x) {
        const int m0 = (tile >> 5) * 128, n0 = (tile & 31) * 128;
        f32x16 acc[2][2]; zero_acc<2>(acc);
        gemm_acc<2>(H + (size_t)m0 * D, D, (const u16*)(p.ws + OFF_W1) + (size_t)n0 * D, D, 1024, acc, (u16*)smem);
        FOR_ACC(acc, m0, n0, { float rl = fmaxf(v, 0.f); HID[(size_t)row * 4096 + col] = f2bf(rl * rl); })
      }
    } break;
    case 10:
      n1024_items(last, [&](int m0, int n0) { mlp2_tile<2>(p, l, m0, n0, smem); }, [&](int m0, int n0) { mlp2_tile<1>(p, l, m0, n0, smem); });
      break;
    case 11: {
      const int nrows = mtiles * 128, rs = gridDim.x * 4;
      float v[16], vn[16];
      int r = blockIdx.x * 4 + w;
      if (r < nrows) ln_load(xrow(p, r), vn);
      for (; r < nrows; r += rs) {
#pragma unroll
        for (int i = 0; i < 16; ++i) v[i] = vn[i];
        if (r + rs < nrows) ln_load(xrow(p, r + rs), vn);
        float* xr = xrow(p, r);
        ln_norm(v);
        ln_affine(v, p.in[33] + l * D, p.in[34] + l * D);
        ln_store_f32(v, xr);
        if (!last) {
          ln_norm(v);
          int bi = bidx_of_row(r);
          ln_store_mod(v, modp(p, l + 1, bi, 0), modp(p, l + 1, bi, 1), (u16*)(p.ws + OFF_H) + (size_t)r * D);
        }
      }
    } break;
  }
}


#define XB_TMO      128
#define XB_XCNT(j)  (256  + 64 * (j))
#define XB_XSUB(j)  (1280 + 64 * (j))
#define XB_XGEN(j)  (2304 + 64 * (j))
#define XB_TOP      3328
#define XB_TOPGEN   3392
#define XCD_BAR_WORDS 3456
#define XB_SPIN_CAP (1u << 22)
#define LAS __attribute__((address_space(3)))
DI unsigned xb_ld(unsigned* p) { return __hip_atomic_load(p, __ATOMIC_RELAXED, __HIP_MEMORY_SCOPE_AGENT); }
DI unsigned xb_add(unsigned* p, unsigned v) { return __hip_atomic_fetch_add(p, v, __ATOMIC_RELAXED, __HIP_MEMORY_SCOPE_AGENT); }
DI unsigned xb_xcc_id() { return (unsigned)__builtin_amdgcn_s_getreg((3 << 11) | 20) & 0xFu; }
#define XB_SPIN(cond, bar) do { unsigned _sp = 0; while (cond) { __builtin_amdgcn_s_sleep(1); \
    if ((++_sp & 255u) == 0u) { if (xb_ld(&(bar)[XB_TMO])) break; if (_sp > XB_SPIN_CAP) { atomicAdd(&(bar)[XB_TMO], 1u); break; } } } } while (0)
struct XcdBarrier { unsigned* bar; unsigned x; volatile LAS unsigned* st; };
DI XcdBarrier xcd_barrier_post(unsigned* bar, volatile LAS unsigned* st) {
  XcdBarrier b; b.bar = bar; b.x = xb_xcc_id(); b.st = st;
  if (threadIdx.x == 0) (void)xb_add(&bar[XB_XCNT(b.x)], 1u);
  return b;
}
DI void xcd_barrier_complete(unsigned* bar, unsigned x, unsigned& nloc, unsigned& nx) {
  const unsigned G = gridDim.x * gridDim.y * gridDim.z;
  unsigned sum, cnt, mine, sp = 0u;
  for (;;) {
    sum = 0u; cnt = 0u; mine = 0u;
#pragma unroll
    for (unsigned j = 0; j < 16; ++j) { const unsigned c = xb_ld(&bar[XB_XCNT(j)]); sum += c; cnt += (c > 0u) ? 1u : 0u; mine = (j == x) ? c : mine; }
    if (sum == G) break;
    __builtin_amdgcn_s_sleep(1);
    if ((++sp & 255u) == 0u) { if (xb_ld(&bar[XB_TMO])) break; if (sp > XB_SPIN_CAP) { atomicAdd(&bar[XB_TMO], 1u); break; } }
  }
  nloc = mine > 0u ? mine : 1u; nx = cnt > 0u ? cnt : 1u;
}
DI void xcd_barrier(const XcdBarrier& b) {
  asm volatile("s_waitcnt vmcnt(0)" ::: "memory");
  __syncthreads();
  if (threadIdx.x == 0) {
    unsigned* bar = b.bar;
    __builtin_amdgcn_s_waitcnt(0);
    unsigned nloc = b.st[0], nx = b.st[1];
    if (nloc == 0u) { xcd_barrier_complete(bar, b.x, nloc, nx); b.st[0] = nloc; b.st[1] = nx; }
    const unsigned old = xb_add(&bar[XB_XSUB(b.x)], 1u);
    const unsigned gen = old / nloc;
    if (old + 1u == (gen + 1u) * nloc) {
      __builtin_amdgcn_fence(__ATOMIC_RELEASE, "agent");
      asm volatile("s_waitcnt vmcnt(0)" ::: "memory");
      const unsigned og = xb_add(&bar[XB_TOP], 1u);
      const unsigned tg = og / nx;
      if (og + 1u == (tg + 1u) * nx) xb_add(&bar[XB_TOPGEN], 1u);
      else XB_SPIN(xb_ld(&bar[XB_TOPGEN]) == tg, bar);
      __builtin_amdgcn_fence(__ATOMIC_ACQUIRE, "agent");
      xb_add(&bar[XB_XGEN(b.x)], 1u);
      asm volatile("s_waitcnt vmcnt(0)" ::: "memory");
    } else {
      XB_SPIN(xb_ld(&bar[XB_XGEN(b.x)]) == gen, bar);
      __builtin_amdgcn_fence(__ATOMIC_ACQUIRE, "agent");
      asm volatile("s_waitcnt vmcnt(0)" ::: "memory");
    }
  }
  __syncthreads();
}

constexpr int NPHASE = 25;

__global__ void __launch_bounds__(256, 2) fwd_kernel(Params p) {
  extern __shared__ __attribute__((aligned(16))) char smem[];
  __shared__ uint4 xb_words;
  cg::grid_group grid = cg::this_grid();
  if (p.ph_lo > 1000) grid.sync();
  if (threadIdx.x == 0) xb_words = make_uint4(0u, 0u, 0u, 0u);
  __syncthreads();
  XcdBarrier xb = xcd_barrier_post((unsigned*)(p.ws + OFF_BAR), (volatile LAS unsigned*)&xb_words);
  for (int ph = p.ph_lo; ph < p.ph_hi; ++ph) {
    run_phase(p, ph, smem);
    if (ph + 1 < p.ph_hi) xcd_barrier(xb);
  }
}

extern "C" void kernel_launch(void* const* d_in, const int* in_sizes, int n_in, void* d_out, int out_size, void* d_ws, size_t ws_size,
                              hipStream_t stream) {
  static int grid_blocks = 0;
  if (!grid_blocks) {
    int dev = 0, cus = 0, per_cu = 0;
    hipGetDevice(&dev);
    hipDeviceGetAttribute(&cus, hipDeviceAttributeMultiprocessorCount, dev);
    hipFuncSetAttribute((const void*)fwd_kernel, hipFuncAttributeMaxDynamicSharedMemorySize, SMEM_BYTES);
    hipOccupancyMaxActiveBlocksPerMultiprocessor(&per_cu, (const void*)fwd_kernel, 256, SMEM_BYTES);
    if (per_cu < 1) per_cu = 1;
    if (per_cu > 2) per_cu = 2;
    grid_blocks = cus * per_cu;
    if (ws_size < OFF_END) fprintf(stderr, "kernel_launch: workspace too small: %zu < %zu\n", ws_size, (size_t)OFF_END);
  }
  Params p{};
  for (int i = 0; i < 35; ++i) p.in[i] = (const float*)d_in[i];
  p.out = (float*)d_out;
  p.ws = (char*)d_ws;
#if SINGLE_LAUNCH
  hipMemsetAsync((char*)d_ws + OFF_BAR, 0, XCD_BAR_WORDS * sizeof(unsigned), stream);
  p.ph_lo = 0; p.ph_hi = NPHASE;
  void* args[] = {&p};
  hipError_t e = hipLaunchCooperativeKernel((const void*)fwd_kernel, dim3(grid_blocks), dim3(256), args, SMEM_BYTES, stream);
  if (e != hipSuccess) fprintf(stderr, "cooperative launch failed: %s (grid %d)\n", hipGetErrorString(e), grid_blocks);
#else
  for (int ph = 0; ph < NPHASE; ++ph) {
    p.ph_lo = ph; p.ph_hi = ph + 1;
    hipLaunchKernelGGL(fwd_kernel, dim3(grid_blocks), dim3(256), SMEM_BYTES, stream, p);
  }
#endif
}
```
